# Optimizing an MI355X kernel written in HIP

```python
import math
import jax, jax.numpy as jnp
from jax import lax
import numpy as np

D_MODEL = 1024
BATCH = 8
SEQ = 4096
DEPTH = 2

EPS = 1e-6
A_HEADS = 8
A_DHEAD = 64
A_QK = A_HEADS * 2 * A_DHEAD
A_V = A_HEADS * 2 * A_DHEAD
Q_BLOCK = 128
M_HEADS = 8
M_DQK = 64
M_DV = 128
M_QK = M_HEADS * M_DQK
M_V = M_HEADS * M_DV
CONV_K = 4
CHUNK = 64
F_BIAS_OFFSET = 3.0
D_FF = 2816
FFN_SCALE = 0.5
SPLIT_SIZES = [A_QK, A_QK, A_V, M_QK, M_QK, M_V, M_V, M_HEADS, M_HEADS, 2 * D_MODEL]
SPLIT_IDX = [int(v) for v in np.cumsum(SPLIT_SIZES)[:-1]]
C_IN = int(sum(SPLIT_SIZES))

kernel_name = "hybrid_diffattn_mlstm_macaron"


def rmsnorm(x, w):
    xf = x.astype(jnp.float32)
    y = xf * lax.rsqrt(jnp.mean(xf * xf, axis=-1, keepdims=True) + EPS)
    return (y * w.astype(jnp.float32)).astype(x.dtype)


def swiglu(h, w_gu, w_down):
    g, u = jnp.split(h @ w_gu, 2, axis=-1)
    return (jax.nn.silu(g) * u) @ w_down


def causal_depthwise_conv(x, w, b):
    c = x.shape[-1]
    y = lax.conv_general_dilated(x, w[:, None, :].astype(x.dtype), window_strides=(1,),
                                 padding=[(CONV_K - 1, 0)],
                                 dimension_numbers=('NWC', 'WIO', 'NWC'),
                                 feature_group_count=c)
    return y + b


def diff_attention(q, k, v, lam, lam_init, norm_w):
    b_, s_, _ = q.shape
    nb = s_ // Q_BLOCK
    scale = A_DHEAD ** -0.5
    qb = q.reshape(b_, nb, Q_BLOCK, A_HEADS, 2, A_DHEAD).transpose(1, 0, 3, 4, 2, 5)
    kh = k.reshape(b_, s_, A_HEADS, 2, A_DHEAD).transpose(0, 2, 3, 1, 4)
    vh = v.reshape(b_, s_, A_HEADS, 2 * A_DHEAD).transpose(0, 2, 1, 3)
    k_pos = jnp.arange(s_)
    lam32 = lam.astype(jnp.float32)

    def block(args):
        qblk, idx = args
        sc = jnp.einsum('bhmqd,bhmkd->bhmqk', qblk, kh).astype(jnp.float32) * scale
        q_pos = idx * Q_BLOCK + jnp.arange(Q_BLOCK)
        causal = k_pos[None, :] <= q_pos[:, None]
        sc = jnp.where(causal, sc, -jnp.inf)
        p = jax.nn.softmax(sc, axis=-1)
        a = p[:, :, 0] - lam32 * p[:, :, 1]
        return jnp.einsum('bhqk,bhkv->bhqv', a.astype(vh.dtype), vh)

    o = lax.map(block, (qb, jnp.arange(nb)))
    o = o.transpose(1, 0, 3, 2, 4).reshape(b_, s_, A_HEADS, 2 * A_DHEAD)
    o = rmsnorm(o, norm_w) * (1.0 - lam_init)
    return o.reshape(b_, s_, A_V)


def mlstm_chunkwise(q, k, v, ig, fg):
    b_, s_ = q.shape[:2]
    nc = s_ // CHUNK
    f32 = jnp.float32

    def chunk(t, d):
        return t.astype(f32).reshape(b_, nc, CHUNK, M_HEADS, d).transpose(0, 3, 1, 2, 4)

    qc = chunk(q, M_DQK) * (M_DQK ** -0.5)
    kc = chunk(k, M_DQK)
    vc = chunk(v, M_DV)
    igc = ig.astype(f32).reshape(b_, nc, CHUNK, M_HEADS).transpose(0, 3, 1, 2)
    logf = jax.nn.log_sigmoid(fg.astype(f32)).reshape(b_, nc, CHUNK, M_HEADS).transpose(0, 3, 1, 2)
    bcum = jnp.cumsum(logf, axis=-1)
    b_last = bcum[..., -1]

    a = b_last[..., None] - bcum + igc
    m_loc = jnp.max(a, axis=-1)
    w = jnp.exp(a - m_loc[..., None])
    c_loc = jnp.einsum('bhcl,bhcld,bhclv->bhcdv', w, kc, vc)
    n_loc = jnp.einsum('bhcl,bhcld->bhcd', w, kc)

    def step(carry, xs):
        c_st, n_st, m_st = carry
        bl, ml, cl, nl = xs
        m_new = jnp.maximum(bl + m_st, ml)
        sp = jnp.exp(bl + m_st - m_new)
        sl = jnp.exp(ml - m_new)
        c_new = sp[..., None, None] * c_st + sl[..., None, None] * cl
        n_new = sp[..., None] * n_st + sl[..., None] * nl
        return (c_new, n_new, m_new), (c_st, n_st, m_st)

    init = (jnp.zeros((b_, M_HEADS, M_DQK, M_DV), f32),
            jnp.zeros((b_, M_HEADS, M_DQK), f32),
            jnp.zeros((b_, M_HEADS), f32))
    xs = (jnp.moveaxis(b_last, 2, 0), jnp.moveaxis(m_loc, 2, 0),
          jnp.moveaxis(c_loc, 2, 0), jnp.moveaxis(n_loc, 2, 0))
    _, (c_prev, n_prev, m_prev) = lax.scan(step, init, xs)
    c_prev = jnp.moveaxis(c_prev, 0, 2)
    n_prev = jnp.moveaxis(n_prev, 0, 2)
    m_prev = jnp.moveaxis(m_prev, 0, 2)

    tril = jnp.tril(jnp.ones((CHUNK, CHUNK), dtype=bool))
    dmat = bcum[..., :, None] - bcum[..., None, :] + igc[..., None, :]
    dmat = jnp.where(tril, dmat, -jnp.inf)
    m_inter = bcum + m_prev[..., None]
    m_t = jnp.maximum(m_inter, jnp.max(dmat, axis=-1))
    sc_inter = jnp.exp(m_inter - m_t)
    p = jnp.exp(dmat - m_t[..., None]) * jnp.einsum('bhcld,bhcsd->bhcls', qc, kc)
    num = sc_inter[..., None] * jnp.einsum('bhcld,bhcdv->bhclv', qc, c_prev) + \
        jnp.einsum('bhcls,bhcsv->bhclv', p, vc)
    den = sc_inter * jnp.einsum('bhcld,bhcd->bhcl', qc, n_prev) + jnp.sum(p, axis=-1)
    h = num / jnp.maximum(jnp.abs(den), jnp.exp(-m_t))[..., None]
    h = h.transpose(0, 2, 3, 1, 4).reshape(b_, s_, M_HEADS, M_DV)
    return h.astype(q.dtype)


def setup_inputs(seed: int = 0) -> dict:
    key = jax.random.key(seed)
    ks = iter(jax.random.split(key, 32))
    L = DEPTH

    def nrm(shape, scale):
        return scale * jax.random.normal(next(ks), shape, jnp.float32)

    def gain(shape):
        return 1.0 + nrm(shape, 0.05)

    return {
        "x": nrm((BATCH, SEQ, D_MODEL), 1.0),
        "ffn1_norm_pre": gain((L, D_MODEL)),
        "ffn1_w_gu": nrm((L, D_MODEL, 2 * D_FF), D_MODEL ** -0.5),
        "ffn1_w_down": nrm((L, D_FF, D_MODEL), D_FF ** -0.5),
        "ffn1_norm_post": gain((L, D_MODEL)),
        "mix_norm_pre": gain((L, D_MODEL)),
        "w_in": nrm((L, D_MODEL, C_IN), D_MODEL ** -0.5),
        "attn_lam_q1": nrm((L, A_DHEAD), 0.1),
        "attn_lam_k1": nrm((L, A_DHEAD), 0.1),
        "attn_lam_q2": nrm((L, A_DHEAD), 0.1),
        "attn_lam_k2": nrm((L, A_DHEAD), 0.1),
        "attn_norm_w": gain((L, 2 * A_DHEAD)),
        "conv_w": nrm((L, CONV_K, 2 * M_QK), CONV_K ** -0.5),
        "conv_b": nrm((L, 2 * M_QK), 0.02),
        "igate_b": nrm((L, M_HEADS), 0.1),
        "fgate_b": F_BIAS_OFFSET + nrm((L, M_HEADS), 0.5),
        "mlstm_norm_w": gain((L, M_HEADS, M_DV)),
        "w_proj_a": nrm((L, A_V, D_MODEL), A_V ** -0.5),
        "w_proj_m": nrm((L, M_V, D_MODEL), M_V ** -0.5),
        "gate_b": nrm((L, 2 * D_MODEL), 0.01),
        "w_out": nrm((L, D_MODEL, D_MODEL), D_MODEL ** -0.5),
        "mix_norm_post": gain((L, D_MODEL)),
        "ffn2_norm_pre": gain((L, D_MODEL)),
        "ffn2_w_gu": nrm((L, D_MODEL, 2 * D_FF), D_MODEL ** -0.5),
        "ffn2_w_down": nrm((L, D_FF, D_MODEL), D_FF ** -0.5),
        "ffn2_norm_post": gain((L, D_MODEL)),
    }


def reference(x, ffn1_norm_pre, ffn1_w_gu, ffn1_w_down, ffn1_norm_post, mix_norm_pre, w_in,
              attn_lam_q1, attn_lam_k1, attn_lam_q2, attn_lam_k2, attn_norm_w, conv_w, conv_b,
              igate_b, fgate_b, mlstm_norm_w, w_proj_a, w_proj_m, gate_b, w_out, mix_norm_post,
              ffn2_norm_pre, ffn2_w_gu, ffn2_w_down, ffn2_norm_post):
    b_, s_, _ = x.shape
    for l in range(DEPTH):
        h = rmsnorm(x, ffn1_norm_pre[l])
        x = x + FFN_SCALE * rmsnorm(swiglu(h, ffn1_w_gu[l], ffn1_w_down[l]), ffn1_norm_post[l])

        h = rmsnorm(x, mix_norm_pre[l])
        z = h @ w_in[l]
        aq, ak, av, mq, mk, mv, mo, mi, mf, gl = jnp.split(z, SPLIT_IDX, axis=-1)

        lam_init = 0.8 - 0.6 * math.exp(-0.3 * l)
        lam = (jnp.exp(jnp.sum(attn_lam_q1[l] * attn_lam_k1[l]))
               - jnp.exp(jnp.sum(attn_lam_q2[l] * attn_lam_k2[l])) + lam_init)
        ya = diff_attention(aq, ak, av, lam, lam_init, attn_norm_w[l])

        mqk = jax.nn.silu(causal_depthwise_conv(jnp.concatenate([mq, mk], axis=-1), conv_w[l], conv_b[l]))
        mq_c, mk_c = jnp.split(mqk, 2, axis=-1)
        hm = mlstm_chunkwise(mq_c.reshape(b_, s_, M_HEADS, M_DQK),
                             mk_c.reshape(b_, s_, M_HEADS, M_DQK),
                             mv.reshape(b_, s_, M_HEADS, M_DV),
                             mi + igate_b[l], mf + fgate_b[l])
        ym = (jax.nn.sigmoid(mo) * rmsnorm(hm, mlstm_norm_w[l]).reshape(b_, s_, M_V))

        g_a, g_m = jnp.split(jax.nn.sigmoid(gl + gate_b[l]), 2, axis=-1)
        merged = g_a * (ya @ w_proj_a[l]) + g_m * (ym @ w_proj_m[l])
        x = x + rmsnorm(merged @ w_out[l], mix_norm_post[l])

        h = rmsnorm(x, ffn2_norm_pre[l])
        x = x + FFN_SCALE * rmsnorm(swiglu(h, ffn2_w_gu[l], ffn2_w_down[l]), ffn2_norm_post[l])
    return x
```

```cpp
#include <hip/hip_runtime.h>
#include <cstdio>
#include <cstdint>
namespace pg8 {
#define PG8_LAS __attribute__((address_space(3)))
typedef unsigned short bf16_t;
typedef short bf16x8 __attribute__((ext_vector_type(8)));
typedef float f32x4 __attribute__((ext_vector_type(4)));
typedef unsigned u32x4 __attribute__((ext_vector_type(4)));
constexpr int BM = 256, BK = 64, HALF = 128, HTB = HALF * BK * 2  , STAGE_BYTES = 8 * HTB, NXCD = 8, WGM = 8;

__host__ __device__ __forceinline__ int lds_byte(int r, int c) { const int st = (r >> 4) * 2 + (c >> 5), rr = r & 15, cc = c & 31, ob = rr * 64 + cc * 2; return st * 1024 + (ob ^ (((ob >> 9) & 1) << 5)); }
__host__ __device__ __forceinline__ void stage_rc(int b, int& R, int& C) { const int st = b / 1024, sb = b % 1024, swz = sb ^ (((sb >> 9) & 1) << 5); R = (st >> 1) * 16 + swz / 64; C = (st & 1) * 32 + (swz % 64) / 2; }
__host__ __device__ __forceinline__ int perm32(int rho) { const int n = rho >> 4, i = rho & 15; return 8 * (i >> 2) + 4 * n + (i & 3); }

struct Unit { int pm, pn; };
struct Gemm { const bf16_t* A; const bf16_t* Bt; int M, N, K; };

struct StaticOrder {
    int nM, nN, nwg, G, c;
    __host__ __device__ void init(int M, int N, int G_, int c_) { nM = M / BM; nN = N / BM; nwg = nM * nN; G = G_; c = c_; }
    __host__ __device__ bool next(int i, Unit& u) const {
        const long L = (long)i * G + c; if (L >= nwg) return false;
        int wgid = (int)L; { const int q = nwg / NXCD, r = nwg % NXCD, xcd = wgid % NXCD, off = wgid / NXCD; wgid = (xcd < r ? xcd * (q + 1) : r * (q + 1) + (xcd - r) * q) + off; }
        const int nig = WGM * nN, gid = wgid / nig, fm = gid * WGM, gsz = (nM - fm) < WGM ? (nM - fm) : WGM;
        u.pm = fm + ((wgid % nig) % gsz); u.pn = (wgid % nig) / gsz; return true;
    }
    __device__ __forceinline__ void a_ready(const Unit&) const {}
    __device__ __forceinline__ void done(const Unit&) const {}
};

__device__ __forceinline__ unsigned cvt_pk_bf16(float lo, float hi) { unsigned r; asm volatile("v_cvt_pk_bf16_f32 %0, %1, %2" : "=v"(r) : "v"(lo), "v"(hi)); return r; }
typedef float f32x2 __attribute__((ext_vector_type(2)));
__device__ __forceinline__ f32x2 gelu_pk(f32x2 v) {
    const f32x2 av = __builtin_elementwise_abs(v), d = av * 0.2316418882f + 1.0f;
    f32x2 t; t.x = __builtin_amdgcn_rcpf(d.x); t.y = __builtin_amdgcn_rcpf(d.y);
    f32x2 q = t * 0.5307027145f + (-0.7265760135f); q = q * t + 0.7107068705f; q = q * t + (-0.142248368f); q = q * t + 0.127414796f; q = q * t;
    const f32x2 s = (v * v) * (-0.72134752044f);
    f32x2 e; e.x = __builtin_amdgcn_exp2f(s.x); e.y = __builtin_amdgcn_exp2f(s.y);
    const f32x2 m = v * (q * e), r = v - m;
    f32x2 o; o.x = v.x < 0.f ? m.x : r.x; o.y = v.y < 0.f ? m.y : r.y; return o;
}

template <int ACT  > struct EpiBf16 {
    static constexpr bool PERM = true, AFTER_DRAIN = false; static_assert(ACT == 0 || ACT == 1, "EpiBf16: ACT is 0 (none) or 1 (gelu_pk)");
    bf16_t* O; int ldc; const float* bias; int split_cols; size_t split_stride; float scale0;
    __device__ __forceinline__ void operator()(const f32x4 (&acc)[2][2][4][2], const Unit& u, int wr, int wc, int fr, int fq) const {
        const int row0 = u.pm * BM + wr * 64 + fr; int colt = u.pn * BM; bf16_t* base = O;
        float sc = 1.f; if (split_cols) { const int t = colt / split_cols; base += (size_t)t * split_stride; colt -= t * split_cols; if (t == 0) sc = scale0; }
        const int col0 = colt + wc * 32 + 8 * fq, bcol0 = u.pn * BM + wc * 32 + 8 * fq;
        f32x4 bv[2][2];
#pragma unroll
        for (int bj = 0; bj < 2; ++bj)
#pragma unroll
            for (int n = 0; n < 2; ++n) bv[bj][n] = bias ? *(const f32x4*)(bias + bcol0 + bj * HALF + 4 * n) : (f32x4){0.f, 0.f, 0.f, 0.f};
#pragma unroll
        for (int ai = 0; ai < 2; ++ai)
#pragma unroll
            for (int m = 0; m < 4; ++m) { bf16_t* rowp = base + (size_t)(row0 + ai * HALF + m * 16) * ldc + col0;
#pragma unroll
                for (int bj = 0; bj < 2; ++bj) { f32x4 v0 = acc[ai][bj][m][0] + bv[bj][0], v1 = acc[ai][bj][m][1] + bv[bj][1];
                    if (ACT == 1) { f32x2 a = gelu_pk((f32x2){v0[0], v0[1]}), b = gelu_pk((f32x2){v0[2], v0[3]}), c = gelu_pk((f32x2){v1[0], v1[1]}), d = gelu_pk((f32x2){v1[2], v1[3]});
                        v0 = (f32x4){a.x, a.y, b.x, b.y}; v1 = (f32x4){c.x, c.y, d.x, d.y}; }
                    v0 = v0 * sc; v1 = v1 * sc; u32x4 w; w.x = cvt_pk_bf16(v0[0], v0[1]); w.y = cvt_pk_bf16(v0[2], v0[3]); w.z = cvt_pk_bf16(v1[0], v1[1]); w.w = cvt_pk_bf16(v1[2], v1[3]);
                    *(u32x4*)(rowp + bj * HALF) = w; } }
    }
};
__device__ __forceinline__ float bflo(unsigned w) { return __uint_as_float(w << 16); }
__device__ __forceinline__ float bfhi(unsigned w) { return __uint_as_float(w & 0xffff0000u); }
__device__ __forceinline__ float sigm(float x) { return __builtin_amdgcn_rcpf(1.0f + __builtin_amdgcn_exp2f(-1.4426950408889634f * x)); }
struct EpiSwiglu {
    static constexpr bool PERM = true, AFTER_DRAIN = false;
    bf16_t* O; int ldc;
    __device__ __forceinline__ void operator()(const f32x4 (&acc)[2][2][4][2], const Unit& u, int wr, int wc, int fr, int fq) const {
        const int row0 = u.pm * BM + wr * 64 + fr, col0 = u.pn * HALF + wc * 32 + 8 * fq;
#pragma unroll
        for (int ai = 0; ai < 2; ++ai)
#pragma unroll
            for (int m = 0; m < 4; ++m) { bf16_t* rowp = O + (size_t)(row0 + ai * HALF + m * 16) * ldc + col0;
                float r[8];
#pragma unroll
                for (int n = 0; n < 2; ++n)
#pragma unroll
                    for (int e = 0; e < 4; ++e) { const float g = acc[ai][0][m][n][e], uu = acc[ai][1][m][n][e]; r[n * 4 + e] = g * sigm(g) * uu; }
                u32x4 w; w.x = cvt_pk_bf16(r[0], r[1]); w.y = cvt_pk_bf16(r[2], r[3]); w.z = cvt_pk_bf16(r[4], r[5]); w.w = cvt_pk_bf16(r[6], r[7]);
                *(u32x4*)rowp = w; }
    }
};
template <int MODE> struct EpiMerge {
    static constexpr bool PERM = true, AFTER_DRAIN = false;
    bf16_t* O; const bf16_t* GL; const float* gb;
    __device__ __forceinline__ void operator()(const f32x4 (&acc)[2][2][4][2], const Unit& u, int wr, int wc, int fr, int fq) const {
        const int row0 = u.pm * BM + wr * 64 + fr, col0 = u.pn * BM + wc * 32 + 8 * fq;
        f32x4 bv[2][2];
#pragma unroll
        for (int bj = 0; bj < 2; ++bj)
#pragma unroll
            for (int n = 0; n < 2; ++n) bv[bj][n] = *(const f32x4*)(gb + col0 + bj * HALF + 4 * n);
#pragma unroll
        for (int ai = 0; ai < 2; ++ai)
#pragma unroll
            for (int m = 0; m < 4; ++m) { const size_t off = (size_t)(row0 + ai * HALF + m * 16) * 1024 + col0;
#pragma unroll
                for (int bj = 0; bj < 2; ++bj) { const u32x4 gw = *(const u32x4*)(GL + off + bj * HALF);
                    u32x4 ow = (u32x4){0u, 0u, 0u, 0u}; if (MODE == 1) ow = *(const u32x4*)(O + off + bj * HALF);
                    float r[8];
#pragma unroll
                    for (int e = 0; e < 4; ++e) { const int n = e >> 1, c = (e & 1) * 2;
                        float v0 = acc[ai][bj][m][n][c] * sigm(bflo(gw[e]) + bv[bj][n][c]), v1 = acc[ai][bj][m][n][c + 1] * sigm(bfhi(gw[e]) + bv[bj][n][c + 1]);
                        if (MODE == 1) { v0 += bflo(ow[e]); v1 += bfhi(ow[e]); }
                        r[2 * e] = v0; r[2 * e + 1] = v1; }
                    u32x4 w; w.x = cvt_pk_bf16(r[0], r[1]); w.y = cvt_pk_bf16(r[2], r[3]); w.z = cvt_pk_bf16(r[4], r[5]); w.w = cvt_pk_bf16(r[6], r[7]);
                    *(u32x4*)(O + off + bj * HALF) = w; } }
    }
};
template <class Epi, class Sched, bool ALIGN_EPI = false, bool SP2 = false>
__device__ __forceinline__ void gemm_phase(PG8_LAS unsigned char* lds, const Gemm g, const Sched& S, const Epi& E) {
    int tid_ = threadIdx.x; asm volatile("" : "+v"(tid_));
    const int tid = tid_, wid = __builtin_amdgcn_readfirstlane(tid >> 6), lane = tid & 63, wr = wid >> 2, wc = wid & 3, fr = lane & 15, fq = lane >> 4;
    const int K = g.K, nt = K / BK;
    unsigned voffA[2], voffB[2];
#pragma unroll
    for (int i = 0; i < 2; ++i) { int R, C; stage_rc(tid * 16 + i * 8192, R, C); const int Rb = Epi::PERM ? ((R & ~31) + perm32(R & 31)) : R;
        voffA[i] = (unsigned)(R * K + C) * 2u; voffB[i] = (unsigned)(Rb * K + C) * 2u; }
    const size_t kstep = (size_t)(BK * 2);
    const size_t hstep = (size_t)HALF * K * 2;
    const size_t tstep = 2 * hstep;
    const unsigned ldsw = (unsigned)wid * 1024u;
    const int aoff = lds_byte(wr * 64 + fr, fq * 8), boff = lds_byte(wc * 32 + fr, fq * 8);
#define PG8_SA(b, h) (((b) * 2 + (h)) * HTB)
#define PG8_SB(b, h) ((4 + (b) * 2 + (h)) * HTB)
#define PG8_STAGE(bufoff, gbase, voff) do { _Pragma("unroll") for (int _i = 0; _i < 2; ++_i) \
        __builtin_amdgcn_global_load_lds((const unsigned*)((const char*)(gbase) + (voff)[_i]), (PG8_LAS unsigned*)(lds + (bufoff) + ldsw + _i * 8192), 16, 0, 0); } while (0)
#define PG8_LDA(dst, b, h) do { _Pragma("unroll") for (int m = 0; m < 4; ++m) _Pragma("unroll") for (int k = 0; k < 2; ++k) dst[m][k] = *(const PG8_LAS bf16x8*)(lds + PG8_SA(b, h) + aoff + m * 2048 + k * 1024); } while (0)
#define PG8_LDB(dst, b, h) do { _Pragma("unroll") for (int n = 0; n < 2; ++n) _Pragma("unroll") for (int k = 0; k < 2; ++k) dst[n][k] = *(const PG8_LAS bf16x8*)(lds + PG8_SB(b, h) + boff + n * 2048 + k * 1024); } while (0)
#define PG8_MMA(ai, bj, At, Bt) do { __builtin_amdgcn_s_setprio(1); _Pragma("unroll") for (int m = 0; m < 4; ++m) _Pragma("unroll") for (int n = 0; n < 2; ++n) _Pragma("unroll") for (int k = 0; k < 2; ++k) \
        acc[ai][bj][m][n] = __builtin_amdgcn_mfma_f32_16x16x32_bf16(Bt[n][k], At[m][k], acc[ai][bj][m][n], 0, 0, 0); __builtin_amdgcn_s_setprio(0); } while (0)
#define PG8_WAIT_V(n) asm volatile("s_waitcnt vmcnt(" #n ")" ::: "memory")
#define PG8_WAIT_L(n) asm volatile("s_waitcnt lgkmcnt(" #n ")" ::: "memory")
#define PG8_BAR __builtin_amdgcn_s_barrier()
#define PG8_SCHED __builtin_amdgcn_sched_barrier(0)
    Unit cur, nxt; int ui = 0;
    if (!S.next(0, cur)) return;
    f32x4 acc[2][2][4][2];
#pragma unroll
    for (int a = 0; a < 2; ++a)
#pragma unroll
        for (int b = 0; b < 2; ++b)
#pragma unroll
            for (int m = 0; m < 4; ++m)
#pragma unroll
                for (int n = 0; n < 2; ++n) acc[a][b][m][n] = (f32x4){0.f, 0.f, 0.f, 0.f};
    bf16x8 At[4][2], B0[2][2], B1[2][2];
    const char* cA = (const char*)g.A + (size_t)cur.pm * tstep; const char* cB = (const char*)g.Bt + (size_t)cur.pn * tstep;
    S.a_ready(cur);
    if constexpr (SP2) {
        PG8_STAGE(PG8_SB(0, 0), cB, voffB); PG8_STAGE(PG8_SB(0, 1), cB + hstep, voffB); PG8_STAGE(PG8_SA(0, 0), cA, voffA); PG8_STAGE(PG8_SA(0, 1), cA + hstep, voffA);
        if (wr == 1) PG8_BAR;
        PG8_WAIT_V(2); PG8_BAR;
        PG8_STAGE(PG8_SB(1, 0), cB + kstep, voffB); PG8_STAGE(PG8_SA(1, 0), cA + kstep, voffA); PG8_STAGE(PG8_SB(1, 1), cB + hstep + kstep, voffB);
        PG8_WAIT_V(6); PG8_BAR;
    } else {
        PG8_STAGE(PG8_SB(0, 0), cB, voffB); PG8_STAGE(PG8_SA(0, 0), cA, voffA); PG8_STAGE(PG8_SB(0, 1), cB + hstep, voffB); PG8_STAGE(PG8_SA(0, 1), cA + hstep, voffA);
        if (wr == 1) PG8_BAR;
        PG8_WAIT_V(4); PG8_BAR;
        PG8_STAGE(PG8_SB(1, 0), cB + kstep, voffB); PG8_STAGE(PG8_SA(1, 0), cA + kstep, voffA); PG8_STAGE(PG8_SB(1, 1), cB + hstep + kstep, voffB);
        PG8_WAIT_V(6); PG8_BAR;
    }
    for (;;) {
        const bool has_next = S.next(ui + 1, nxt);
        const char* nA = has_next ? (const char*)g.A + (size_t)nxt.pm * tstep : cA; const char* nB = has_next ? (const char*)g.Bt + (size_t)nxt.pn * tstep : cB;
        for (int t = 0; t < nt; t += 2) {
            const bool last = (t == nt - 2);
            const char* a1 = cA + (size_t)(t + 1) * kstep;
            const char* a2 = last ? nA : cA + (size_t)(t + 2) * kstep; const char* b2 = last ? nB : cB + (size_t)(t + 2) * kstep;
            const char* a3 = a2 + kstep; const char* b3 = b2 + kstep;
            if (last && has_next) S.a_ready(nxt);
            if constexpr (SP2) {
            PG8_LDB(B0, 0, 0); PG8_LDB(B1, 0, 1); PG8_SCHED; PG8_LDA(At, 0, 0); PG8_STAGE(PG8_SA(1, 1), a1 + hstep, voffA);
            PG8_WAIT_V(8); PG8_WAIT_L(0); PG8_BAR; PG8_MMA(0, 0, At, B0); PG8_MMA(0, 1, At, B1); PG8_BAR; PG8_SCHED;
            PG8_LDA(At, 0, 1); PG8_STAGE(PG8_SB(0, 0), b2, voffB); PG8_STAGE(PG8_SB(0, 1), b2 + hstep, voffB); PG8_STAGE(PG8_SA(0, 0), a2, voffA);
            PG8_WAIT_V(8); PG8_WAIT_L(0); PG8_BAR; PG8_MMA(1, 0, At, B0); PG8_MMA(1, 1, At, B1); PG8_BAR; PG8_SCHED;
            PG8_LDB(B0, 1, 0); PG8_LDB(B1, 1, 1); PG8_SCHED; PG8_LDA(At, 1, 0); PG8_STAGE(PG8_SA(0, 1), a2 + hstep, voffA);
            PG8_WAIT_V(8); PG8_WAIT_L(0); PG8_BAR; PG8_MMA(0, 0, At, B0); PG8_MMA(0, 1, At, B1); PG8_BAR; PG8_SCHED;
            PG8_LDA(At, 1, 1); PG8_STAGE(PG8_SB(1, 0), b3, voffB); PG8_STAGE(PG8_SB(1, 1), b3 + hstep, voffB); PG8_STAGE(PG8_SA(1, 0), a3, voffA);
            PG8_WAIT_V(8); PG8_WAIT_L(0); PG8_BAR; PG8_MMA(1, 0, At, B0); PG8_MMA(1, 1, At, B1); PG8_BAR; PG8_SCHED;
            } else {
            PG8_LDB(B0, 0, 0); PG8_SCHED; PG8_LDA(At, 0, 0); PG8_STAGE(PG8_SA(1, 1), a1 + hstep, voffA);
            PG8_WAIT_L(8); PG8_BAR; PG8_WAIT_L(0); PG8_MMA(0, 0, At, B0); PG8_BAR; PG8_SCHED;
            PG8_LDB(B1, 0, 1); PG8_STAGE(PG8_SB(0, 0), b2, voffB);
            PG8_BAR; PG8_WAIT_L(0); PG8_MMA(0, 1, At, B1); PG8_BAR;
            PG8_LDA(At, 0, 1); PG8_STAGE(PG8_SA(0, 0), a2, voffA);
            PG8_BAR; PG8_WAIT_L(0); PG8_MMA(1, 0, At, B0); PG8_BAR; PG8_SCHED;
            PG8_STAGE(PG8_SB(0, 1), b2 + hstep, voffB);
            PG8_WAIT_V(6); PG8_BAR; PG8_MMA(1, 1, At, B1); PG8_BAR;
            PG8_LDB(B0, 1, 0); PG8_SCHED; PG8_LDA(At, 1, 0); PG8_STAGE(PG8_SA(0, 1), a2 + hstep, voffA);
            PG8_WAIT_L(8); PG8_BAR; PG8_WAIT_L(0); PG8_MMA(0, 0, At, B0); PG8_BAR; PG8_SCHED;
            PG8_LDB(B1, 1, 1); PG8_STAGE(PG8_SB(1, 0), b3, voffB);
            PG8_BAR; PG8_WAIT_L(0); PG8_MMA(0, 1, At, B1); PG8_BAR;
            PG8_LDA(At, 1, 1); PG8_STAGE(PG8_SA(1, 0), a3, voffA);
            PG8_BAR; PG8_WAIT_L(0); PG8_MMA(1, 0, At, B0); PG8_BAR; PG8_SCHED;
            PG8_STAGE(PG8_SB(1, 1), b3 + hstep, voffB);
            PG8_WAIT_V(6); PG8_BAR; PG8_MMA(1, 1, At, B1); PG8_BAR;
            }
        }
        if constexpr (ALIGN_EPI) { if (wr == 0) PG8_BAR; }
        if constexpr (!Epi::AFTER_DRAIN) { E(acc, cur, wr, wc, fr, fq); S.done(cur); }
        if (!has_next) break;
#pragma unroll
        for (int a = 0; a < 2; ++a)
#pragma unroll
            for (int b = 0; b < 2; ++b)
#pragma unroll
                for (int m = 0; m < 4; ++m)
#pragma unroll
                    for (int n = 0; n < 2; ++n) acc[a][b][m][n] = (f32x4){0.f, 0.f, 0.f, 0.f};
        cur = nxt; cA = nA; cB = nB; ++ui;
        if constexpr (ALIGN_EPI) { if (wr == 1) PG8_BAR; }
    }
    PG8_WAIT_V(0);
    if constexpr (!ALIGN_EPI) { if (wr == 0) PG8_BAR; }
    PG8_BAR;
    if constexpr (Epi::AFTER_DRAIN) { E.fused(acc, cur, wr, wc, fr, fq, lds, wid, lane); S.done(cur); }
#undef PG8_SA
#undef PG8_SB
#undef PG8_STAGE
#undef PG8_LDA
#undef PG8_LDB
#undef PG8_MMA
#undef PG8_WAIT_V
#undef PG8_WAIT_L
#undef PG8_BAR
#undef PG8_SCHED
}
}

#ifndef PG8_SP2
#define PG8_SP2 true
#endif
#ifndef PG8_ALIGN
#define PG8_ALIGN true
#endif
#include <hip/hip_bf16.h>
#include <cmath>
namespace attn_body {
using bf16=__hip_bfloat16;
using bf16x8=__attribute__((ext_vector_type(8)))short;
using s16x4=__attribute__((ext_vector_type(4)))short;
using f32x16=__attribute__((ext_vector_type(16)))float;
using u32x4=__attribute__((ext_vector_type(4)))unsigned;
constexpr int BATCH=4,NHEAD=16,SEQ=4096,D=64,DM=NHEAD*D;
constexpr int NW=8,QBLK=32,QB=QBLK*NW,KVBLK=64,NQB=SEQ/QB;
constexpr int ATTN_PITCH=DM, ATTN_UNIT_ROWS=QB;
__device__ __forceinline__ int crow(int r,int hi){return (r&3)+8*(r>>2)+4*hi;}
#define SBAR() __builtin_amdgcn_sched_barrier(0)
__device__ __forceinline__ void cmask(f32x16&p0,f32x16&p1,int jb,int qrel,int hi){
  const float NEG=-INFINITY; int kb=64*jb+4*hi;
  #pragma unroll
  for(int r=0;r<16;++r){int kv=kb+(r&3)+8*(r>>2); if(kv>qrel)p0[r]=NEG; if(kv+32>qrel)p1[r]=NEG;}
}

constexpr int NSLOT=3, SLOTB=8192;
constexpr int LDS_K=0, LDS_V=NSLOT*SLOTB, LDS_WS=2*NSLOT*SLOTB, LDS_OST=LDS_WS+NW*64*4, LDS_BYTES=LDS_OST+NW*4096;
constexpr float C2=0.125f*1.4426950408889634f;
__device__ __forceinline__ void glds16(const void*gsrc,unsigned lds_dst){unsigned keep;
  asm volatile("s_mov_b32 %0, m0\n\ts_mov_b32 m0, %2\n\ts_nop 0\n\tglobal_load_lds_dwordx4 %1, off\n\ts_mov_b32 m0, %0":"=&s"(keep):"v"(gsrc),"s"(lds_dst):"memory");}
__device__ __forceinline__ float max3f(float a,float b,float c){float r;asm("v_max3_f32 %0, %1, %2, %3":"=v"(r):"v"(a),"v"(b),"v"(c));return r;}
__device__ __forceinline__ float max2f(float a,float b){float r;asm("v_max_f32_e32 %0, %1, %2":"=v"(r):"v"(a),"v"(b));return r;}
__device__ __forceinline__ float fadd_s(float a,float b){float r;asm("v_add_f32_e32 %0, %1, %2":"=v"(r):"v"(a),"v"(b));return r;}
__device__ __forceinline__ float fsub_s(float a,float b){float r;asm("v_sub_f32_e32 %0, %1, %2":"=v"(r):"v"(a),"v"(b));return r;}
typedef float f32x2_t __attribute__((ext_vector_type(2))); typedef __bf16 bf16x2_t __attribute__((ext_vector_type(2)));
__device__ __forceinline__ unsigned cvtpk_s(float lo,float hi){f32x2_t v={lo,hi};bf16x2_t b=__builtin_convertvector(v,bf16x2_t);return __builtin_bit_cast(unsigned,b);}
#define WAIT_BAR(N) asm volatile("s_waitcnt vmcnt(" #N ") lgkmcnt(0)\n\ts_barrier":::"memory")

__device__ __forceinline__ void qkt(f32x16&p0,f32x16&p1,const char*Kslot,const bf16x8*qr,const f32x16&negm,int r32,int hi){
  const char*kb=Kslot+hi*1024+r32*16;
  #pragma unroll
  for(int d0=0;d0<4;++d0){
    const bf16x8 b0=*reinterpret_cast<const bf16x8*>(kb+d0*2048);
    const bf16x8 b1=*reinterpret_cast<const bf16x8*>(kb+d0*2048+512);
    if(d0==0){p0=__builtin_amdgcn_mfma_f32_32x32x16_bf16(b0,qr[0],negm,0,0,0);p1=__builtin_amdgcn_mfma_f32_32x32x16_bf16(b1,qr[0],negm,0,0,0);}
    else{p0=__builtin_amdgcn_mfma_f32_32x32x16_bf16(b0,qr[d0],p0,0,0,0);p1=__builtin_amdgcn_mfma_f32_32x32x16_bf16(b1,qr[d0],p1,0,0,0);}}
}
typedef __attribute__((address_space(3))) const char* lds_cptr;
typedef short v4i16_t __attribute__((ext_vector_type(4)));
__device__ __forceinline__ void kload8(bf16x8*kf,lds_cptr kp){
  kf[0]=*(const __attribute__((address_space(3))) bf16x8*)(kp);      kf[1]=*(const __attribute__((address_space(3))) bf16x8*)(kp+512);
  kf[2]=*(const __attribute__((address_space(3))) bf16x8*)(kp+2048); kf[3]=*(const __attribute__((address_space(3))) bf16x8*)(kp+2560);
  kf[4]=*(const __attribute__((address_space(3))) bf16x8*)(kp+4096); kf[5]=*(const __attribute__((address_space(3))) bf16x8*)(kp+4608);
  kf[6]=*(const __attribute__((address_space(3))) bf16x8*)(kp+6144); kf[7]=*(const __attribute__((address_space(3))) bf16x8*)(kp+6656);
}
__device__ __forceinline__ void kload2(bf16x8*kf,lds_cptr kp,int j){ kf[2*j]=*(const __attribute__((address_space(3))) bf16x8*)(kp+j*2048); kf[2*j+1]=*(const __attribute__((address_space(3))) bf16x8*)(kp+j*2048+512); }
__device__ __forceinline__ s16x4 vtr(lds_cptr p){ return __builtin_bit_cast(s16x4,__builtin_amdgcn_ds_read_tr16_b64_v4i16((__attribute__((address_space(3))) v4i16_t*)p)); }
__device__ __forceinline__ float rowmax(const f32x16&p0,const f32x16&p1){
  float a=max3f(p0[0],p0[1],p1[0]),b=max3f(p0[2],p0[3],p1[1]);a=max3f(a,p1[2],p1[3]);
  #pragma unroll
  for(int r=4;r<16;r+=4){a=max3f(a,p0[r],p0[r+1]);b=max3f(b,p0[r+2],p0[r+3]);a=max3f(a,p1[r],p1[r+1]);b=max3f(b,p1[r+2],p1[r+3]);}
  const float m=max2f(a,b);
  auto rr=__builtin_amdgcn_permlane32_swap(__float_as_uint(m),__float_as_uint(m),false,false);
  return max2f(__uint_as_float(rr[0]),__uint_as_float(rr[1]));
}
__device__ __forceinline__ void pv(f32x16*o,int vb,bf16x8 pa0,bf16x8 pa1,bf16x8 pa2,bf16x8 pa3){
  #pragma unroll
  for(int d0=0;d0<2;++d0){s16x4 lo[4],hi[4];
    #pragma unroll
    for(int ks=0;ks<4;++ks){
      asm volatile("ds_read_b64_tr_b16 %0,%1 offset:%c2":"=&v"(lo[ks]):"v"(vb),"i"(d0*4096+ks*1024):"memory");
      asm volatile("ds_read_b64_tr_b16 %0,%1 offset:%c2":"=&v"(hi[ks]):"v"(vb),"i"(d0*4096+ks*1024+512):"memory");}
    asm volatile("s_waitcnt lgkmcnt(0)":::"memory");SBAR();
    #define PK(k) (bf16x8){lo[k][0],lo[k][1],lo[k][2],lo[k][3],hi[k][0],hi[k][1],hi[k][2],hi[k][3]}
    o[d0]=__builtin_amdgcn_mfma_f32_32x32x16_bf16(pa0,PK(0),o[d0],0,0,0);
    o[d0]=__builtin_amdgcn_mfma_f32_32x32x16_bf16(pa1,PK(1),o[d0],0,0,0);
    o[d0]=__builtin_amdgcn_mfma_f32_32x32x16_bf16(pa2,PK(2),o[d0],0,0,0);
    o[d0]=__builtin_amdgcn_mfma_f32_32x32x16_bf16(pa3,PK(3),o[d0],0,0,0);
    #undef PK
  }
}

#ifndef ATTN_STORE16
#define ATTN_STORE16(p,v) (*(u32x4*)(p)=(v))
#endif
template<int THRL> __device__ __forceinline__ void attn_unit(int b,int h,int hv,int qb,const bf16*Q,const bf16*__restrict__ K,const bf16*__restrict__ V,bf16*O,char*shm,int mode,float lam){
  int tid_=threadIdx.x; asm volatile("":"+v"(tid_)); const int tid=tid_,lane=tid&63,r32=lane&31,hi=lane>>5; const int wid=__builtin_amdgcn_readfirstlane(tid>>6);
  const long rowbase=(long)b*SEQ; const int q0=qb*QB;
  const bf16*Qw=Q+(rowbase+q0+wid*QBLK)*DM+h*D;
  const bf16*Kh=K+rowbase*DM+h*D,*Vh=V+rowbase*DM+hv*D;
  const unsigned lds0=(unsigned)(uintptr_t)shm;
  float*wsf=(float*)(shm+LDS_WS)+wid*64;
  const bf16*ksrc=Kh+(long)lane*DM+wid*8;
  const bf16*vsrc=Vh+(long)(16*(wid&3)+(lane>>2))*DM+(wid>>2)*32+(lane&3)*8;
  const unsigned kdst=lds0+LDS_K+wid*1024, vdst=lds0+LDS_V+wid*1024;
  #define DMA_K(t,slot) glds16(ksrc+(long)(t)*KVBLK*DM,(unsigned)__builtin_amdgcn_readfirstlane(kdst+(slot)))
  #define DMA_V(t,slot) glds16(vsrc+(long)(t)*KVBLK*DM,(unsigned)__builtin_amdgcn_readfirstlane(vdst+(slot)))
  const int vb0=(int)(lds0+LDS_V)+((lane>>4)&1)*32+(lane&3)*8+(4*hi+((lane&15)>>2))*64;
  const char*Kbase=shm+LDS_K; bf16x8 kf[8];
  const lds_cptr shm3=(lds_cptr)shm; const lds_cptr kp0=shm3+LDS_K+hi*1024+r32*16; const lds_cptr vp0=shm3+LDS_V+((lane>>4)&1)*32+(lane&3)*8+(4*hi+((lane&15)>>2))*64;
  const int NT=(q0+QB)/KVBLK;
  DMA_K(0,0);DMA_V(0,0);DMA_K(1,SLOTB);
  bf16x8 qr[4];
  #pragma unroll
  for(int d0=0;d0<4;++d0)qr[d0]=*reinterpret_cast<const bf16x8*>(&Qw[(long)r32*DM+d0*16+hi*8]);
  float mhat=0.f,l_reg=0.f;f32x16 o[2];o[0]=f32x16{};o[1]=f32x16{};const f32x16 negm=f32x16{};
  const int qrel=wid*QBLK+r32;
  #define CMASK(P0,P1,t) do{int jb_=(t)-(NT-4); if(jb_>=0)cmask(P0,P1,jb_,qrel,hi);}while(0)
  bool resc=false;
  #define START(P0,P1) do{ const float rm=rowmax(P0,P1); resc=false; \
    { const float dl=rm; mhat=fadd_s(mhat,dl); \
      _Pragma("unroll") for(int r=0;r<16;++r){P0[r]=fsub_s(P0[r],dl);P1[r]=fsub_s(P1[r],dl);} } \
    _Pragma("unroll") for(int r=0;r<16;++r)P0[r]=__builtin_amdgcn_exp2f(P0[r]); }while(0)
  #define RESC() do{ if(resc){ asm volatile("s_waitcnt lgkmcnt(0)":::"memory"); \
      _Pragma("unroll") for(int d_=0;d_<2;++d_) _Pragma("unroll") for(int r=0;r<16;++r)o[d_][r]*=wsf[crow(r,hi)]; } }while(0)
  f32x16 pA0,pA1,pB0,pB1;
  int sl_prev=0,sl_cur=0,sl_next=SLOTB;
  #define ROT() do{sl_prev=sl_cur;sl_cur=sl_next;sl_next=(sl_next==(NSLOT-1)*SLOTB)?0:sl_next+SLOTB;}while(0)
  DMA_K(2,2*SLOTB);
  WAIT_BAR(3);
  qkt(pA0,pA1,Kbase,qr,negm,r32,hi);asm volatile("s_nop 15\n\ts_nop 7":"+v"(pA0),"+v"(pA1));CMASK(pA0,pA1,0);
  START(pA0,pA1);
  _Pragma("unroll") for(int r=0;r<16;++r)pA1[r]=__builtin_amdgcn_exp2f(pA1[r]);
  WAIT_BAR(0);
  DMA_K(3,0);DMA_V(1,SLOTB);
  ROT();
  kload8(kf,kp0+sl_cur);
  WAIT_BAR(2);
  s16x4 vlo[8],vhi[8]; u32x4 pw0,pw1,pw2,pw3;
  #define PKW(P,B) cvtpk_s(P[B],P[B+1])
  #define PAF(k) __builtin_bit_cast(bf16x8,pw##k)
  #define VFR(i) (bf16x8){vlo[i][0],vlo[i][1],vlo[i][2],vlo[i][3],vhi[i][0],vhi[i][1],vhi[i][2],vhi[i][3]}
  #define PIN(x) asm volatile("":"+v"(x))
  #define MX3(a,b,c) __builtin_fmaxf(__builtin_fmaxf((a),(b)),(c))
  #define GAPA(MF,A0,A1,A2,A3,W0,W1,PW) do{ MF; sacc+=A0; sacc+=A1; sacc+=A2; sacc+=A3; PIN(sacc); W0; W1; PIN(PW); SBAR(); }while(0)
  #define EX(v) __builtin_amdgcn_exp2f(v)
  #define GAPB(MF,X,B) do{ MF; X[B]=EX(X[B]); X[B+1]=EX(X[B+1]); X[B+2]=EX(X[B+2]); X[B+3]=EX(X[B+3]); PIN(X); SBAR(); }while(0)
  #define VRD(i) do{ vlo[i]=vtr(vp_+(((i)>>2)*4096+((i)&3)*1024)); vhi[i]=vtr(vp_+(((i)>>2)*4096+((i)&3)*1024+512)); }while(0)
  #define KRD(G,j) do{ if(G){ kload2(kf,kp0+sl_next,j); SBAR(); } }while(0)
  #define STEP(C0,C1,P0,P1,t,GK,GV,GL) do{ SBAR(); \
    const lds_cptr vp_=vp0+sl_prev; \
    VRD(0); SBAR(); float sacc=(P0[0]+P0[1]); \
    GAPA(C0=__builtin_amdgcn_mfma_f32_32x32x16_bf16(kf[0],qr[0],negm,0,0,0), P0[2],P0[3],P0[4],P0[5],     pw0[0]=PKW(P0,0), pw0[1]=PKW(P0,2), pw0); \
    VRD(4); SBAR(); GAPA(C1=__builtin_amdgcn_mfma_f32_32x32x16_bf16(kf[1],qr[0],negm,0,0,0), P0[6],P0[7],P0[8],P0[9],     pw0[2]=PKW(P0,4), pw0[3]=PKW(P0,6), pw0); \
    VRD(1); SBAR(); GAPA(C0=__builtin_amdgcn_mfma_f32_32x32x16_bf16(kf[2],qr[1],C0,0,0,0),   P0[10],P0[11],P0[12],P0[13], pw1[0]=PKW(P0,8), pw1[1]=PKW(P0,10), pw1); \
    VRD(5); SBAR(); GAPA(C1=__builtin_amdgcn_mfma_f32_32x32x16_bf16(kf[3],qr[1],C1,0,0,0),   P0[14],P0[15],P1[0],P1[1],   pw1[2]=PKW(P0,12),pw1[3]=PKW(P0,14), pw1); \
    VRD(2); SBAR(); GAPA(C0=__builtin_amdgcn_mfma_f32_32x32x16_bf16(kf[4],qr[2],C0,0,0,0),   P1[2],P1[3],P1[4],P1[5],     pw2[0]=PKW(P1,0), pw2[1]=PKW(P1,2), pw2); \
    VRD(6); SBAR(); GAPA(C1=__builtin_amdgcn_mfma_f32_32x32x16_bf16(kf[5],qr[2],C1,0,0,0),   P1[6],P1[7],P1[8],P1[9],     pw2[2]=PKW(P1,4), pw2[3]=PKW(P1,6), pw2); \
    VRD(3); SBAR(); GAPA(C0=__builtin_amdgcn_mfma_f32_32x32x16_bf16(kf[6],qr[3],C0,0,0,0),   P1[10],P1[11],P1[12],P1[13], pw3[0]=PKW(P1,8), pw3[1]=PKW(P1,10), pw3); \
    VRD(7); SBAR(); GAPA(C1=__builtin_amdgcn_mfma_f32_32x32x16_bf16(kf[7],qr[3],C1,0,0,0),   P1[14],P1[15],0.f,0.f,       pw3[2]=PKW(P1,12),pw3[3]=PKW(P1,14), pw3); \
    l_reg+=sacc; \
    if(GK){DMA_K((t)+3,sl_cur);} if(GV){DMA_V((t)+1,sl_next);} \
    _Pragma("unroll") for(int r=0;r<16;++r){C0[r]-=mhat;C1[r]-=mhat;} \
    CMASK(C0,C1,t); \
    { float a=MX3(C0[0],C0[1],C1[0]),b=MX3(C0[2],C0[3],C1[1]); a=MX3(a,C1[2],C1[3]); \
      _Pragma("unroll") for(int r=4;r<16;r+=4){a=MX3(a,C0[r],C0[r+1]);b=MX3(b,C0[r+2],C0[r+3]);a=MX3(a,C1[r],C1[r+1]);b=MX3(b,C1[r+2],C1[r+3]);} \
      float rm=__builtin_fmaxf(a,b); { auto rr=__builtin_amdgcn_permlane32_swap(__float_as_uint(rm),__float_as_uint(rm),false,false); rm=__builtin_fmaxf(__uint_as_float(rr[0]),__uint_as_float(rr[1])); } \
      resc=false; \
      if(__builtin_expect(__any(rm>(float)THRL),0)){ const float dl=__builtin_fmaxf(rm,0.f); mhat+=dl; \
        _Pragma("unroll") for(int r=0;r<16;++r){C0[r]-=dl;C1[r]-=dl;} \
        const float f=__builtin_amdgcn_exp2f(-dl); l_reg*=f; if(hi==0)wsf[r32]=f; resc=true; } } \
    SBAR(); \
    GAPB(o[0]=__builtin_amdgcn_mfma_f32_32x32x16_bf16(PAF(0),VFR(0),o[0],0,0,0), C0,0); \
    GAPB(o[1]=__builtin_amdgcn_mfma_f32_32x32x16_bf16(PAF(0),VFR(4),o[1],0,0,0), C0,4); \
    KRD(GL,0); GAPB(o[0]=__builtin_amdgcn_mfma_f32_32x32x16_bf16(PAF(1),VFR(1),o[0],0,0,0), C0,8); \
    KRD(GL,1); GAPB(o[1]=__builtin_amdgcn_mfma_f32_32x32x16_bf16(PAF(1),VFR(5),o[1],0,0,0), C0,12); \
    KRD(GL,2); GAPB(o[0]=__builtin_amdgcn_mfma_f32_32x32x16_bf16(PAF(2),VFR(2),o[0],0,0,0), C1,0); \
    KRD(GL,3); GAPB(o[1]=__builtin_amdgcn_mfma_f32_32x32x16_bf16(PAF(2),VFR(6),o[1],0,0,0), C1,4); \
    GAPB(o[0]=__builtin_amdgcn_mfma_f32_32x32x16_bf16(PAF(3),VFR(3),o[0],0,0,0), C1,8); \
    GAPB(o[1]=__builtin_amdgcn_mfma_f32_32x32x16_bf16(PAF(3),VFR(7),o[1],0,0,0), C1,12); \
    }while(0)
  int t=1;
  #undef CMASK
  #define CMASK(P0,P1,t) do{}while(0)
  for(;t+5<NT;t+=2){
    STEP(pB0,pB1,pA0,pA1,t,true,true,true);     WAIT_BAR(2); RESC(); ROT();
    STEP(pA0,pA1,pB0,pB1,t+1,true,true,true);   WAIT_BAR(2); RESC(); ROT();
  }
  #undef CMASK
  #define CMASK(P0,P1,t) do{int jb_=(t)-(NT-4); if(jb_>=0)cmask(P0,P1,jb_,qrel,hi);}while(0)
  #define ENDW(tt) do{ if((tt)+3<NT){WAIT_BAR(2);} else if((tt)+2<NT){WAIT_BAR(1);} else {WAIT_BAR(0);} }while(0)
  for(;t+1<NT;t+=2){
    STEP(pB0,pB1,pA0,pA1,t,(t+3<NT),(t+1<NT),(t+1<NT));       ENDW(t);   RESC(); ROT();
    STEP(pA0,pA1,pB0,pB1,t+1,(t+4<NT),(t+2<NT),(t+2<NT));     ENDW(t+1); RESC(); ROT();
  }
  STEP(pB0,pB1,pA0,pA1,NT-1,false,false,false); RESC();
  { float sacc=pB0[0]+pB0[1]; _Pragma("unroll") for(int r=2;r<16;++r)sacc+=pB0[r]; _Pragma("unroll") for(int r=0;r<16;++r)sacc+=pB1[r]; l_reg+=sacc;
    pw0=(u32x4){PKW(pB0,0),PKW(pB0,2),PKW(pB0,4),PKW(pB0,6)};pw1=(u32x4){PKW(pB0,8),PKW(pB0,10),PKW(pB0,12),PKW(pB0,14)};pw2=(u32x4){PKW(pB1,0),PKW(pB1,2),PKW(pB1,4),PKW(pB1,6)};pw3=(u32x4){PKW(pB1,8),PKW(pB1,10),PKW(pB1,12),PKW(pB1,14)};
    SBAR(); pv(o,vb0+sl_cur,PAF(0),PAF(1),PAF(2),PAF(3)); }
  #undef PKW
  #undef PAF
  #undef VFR
  #undef PIN
  #undef MX3
  #undef GAPA
  #undef GAPB
  #undef EX
  #undef VRD
  #undef KRD
  #undef STEP
  #undef ENDW
  {auto rr=__builtin_amdgcn_permlane32_swap(__float_as_uint(l_reg),__float_as_uint(l_reg),false,false);l_reg=__uint_as_float(rr[0])+__uint_as_float(rr[1]);}
  if(hi==0)wsf[32+r32]=l_reg;asm volatile("s_waitcnt lgkmcnt(0)":::"memory");
  float rli[16];
  #pragma unroll
  for(int r=0;r<16;++r)rli[r]=__builtin_amdgcn_rcpf(wsf[32+crow(r,hi)]);
  bf16*Ow=O+(rowbase+q0+wid*QBLK)*DM+hv*D;
  { bf16*stg=(bf16*)(shm+LDS_OST)+wid*2048;
    #pragma unroll
    for(int r=0;r<16;++r){const int orow=crow(r,hi);
      #pragma unroll
      for(int d0=0;d0<2;++d0)stg[orow*64+d0*32+r32]=__float2bfloat16(o[d0][r]*rli[r]);}
    asm volatile("s_waitcnt lgkmcnt(0)":::"memory");
    #pragma unroll
    for(int i=0;i<4;++i){const int row=i*8+(lane>>3),ch=lane&7; u32x4 v=*(const u32x4*)(stg+row*64+ch*8);
      if(mode){ const u32x4 ov=*(const u32x4*)(Ow+(long)row*DM+ch*8);
        #pragma unroll
        for(int e=0;e<4;++e){ const float a0=__uint_as_float(ov[e]<<16), a1=__uint_as_float(ov[e]&0xffff0000u), c0=__uint_as_float(v[e]<<16), c1=__uint_as_float(v[e]&0xffff0000u);
          v[e]=cvtpk_s(a0-lam*c0,a1-lam*c1); } }
      ATTN_STORE16(Ow+(long)row*DM+ch*8,v);} }
  asm volatile("s_waitcnt lgkmcnt(0)\n\ts_barrier":::"memory");
  #undef DMA_K
  #undef DMA_V
  #undef CMASK
  #undef START
  #undef RESC
  #undef ROT
}
constexpr int ATTN_LDS_BYTES=LDS_BYTES;
#undef SBAR
#undef WAIT_BAR
}
#include <hip/hip_cooperative_groups.h>
namespace cg = cooperative_groups;
constexpr int NWAVES = 8, NTHR = 512;
constexpr int DEPTH = 2, M = 32768, MH = 16384, DM = 1024, FF = 2816, SEQ = 4096, CIN = 8208;
constexpr float EPS = 1e-6f;
constexpr size_t MiB = 1u << 20;
constexpr size_t WS_WG = 1 * MiB;
constexpr size_t WS_W = 2 * MiB, W_LSTRIDE = 55 * MiB;
constexpr size_t WO_GU1 = 0, WO_DN1 = 11 * MiB, WO_WIN = 11 * MiB + MiB / 2 + 5 * MiB, WO_WA = WO_WIN + 16 * MiB, WO_WM = WO_WA + 2 * MiB, WO_WO = WO_WM + 2 * MiB,
                 WO_GU2 = WO_WO + 2 * MiB, WO_DN2 = WO_GU2 + 11 * MiB;
static_assert(WO_DN2 + 5 * MiB + MiB / 2 == W_LSTRIDE, "weight map");
constexpr size_t WS_XN = 112 * MiB, WS_GATES = 176 * MiB, WS_CST = 178 * MiB, WS_NL = 210 * MiB, WS_BL = WS_NL + 512 * 1024, WS_ML = WS_BL + 64 * 1024, WS_MP = WS_ML + 64 * 1024;
constexpr size_t WS_YA = 212 * MiB, WS_Z = 244 * MiB, ZSTRIDE = 32 * MiB;
constexpr size_t WS_ACT = 212 * MiB, WS_Y = 388 * MiB, WS_END = 500 * MiB;
static_assert(WS_ACT + (size_t)M * FF * 2 <= WS_Y && WS_Y + (size_t)M * DM * 2 <= WS_END && WS_Z + 8 * ZSTRIDE == WS_END, "ws map");
constexpr int RING_BYTES = 131072, LDS_BYTES = 147456;

#define LAS __attribute__((address_space(3)))
typedef unsigned short bf16;
typedef unsigned v4u __attribute__((ext_vector_type(4)));
typedef unsigned v2u __attribute__((ext_vector_type(2)));
typedef float f32x4 __attribute__((ext_vector_type(4)));
typedef short bf16x8 __attribute__((ext_vector_type(8)));
__device__ __forceinline__ float bf2f(bf16 b) { return __uint_as_float((unsigned)b << 16); }
__device__ __forceinline__ float bflo(unsigned w) { return __uint_as_float(w << 16); }
__device__ __forceinline__ float bfhi(unsigned w) { return __uint_as_float(w & 0xffff0000u); }
__device__ __forceinline__ unsigned pkbf(float lo, float hi) { return pg8::cvt_pk_bf16(lo, hi); }
__device__ __forceinline__ unsigned pkbf_c(float lo, float hi) { return attn_body::cvtpk_s(lo, hi); }
__device__ __forceinline__ float sigmf(float x) { return 1.0f / (1.0f + __expf(-x)); }
__device__ __forceinline__ float wave_sum(float v) {
#pragma unroll
    for (int o = 1; o < 64; o <<= 1) v += __shfl_xor(v, o);
    return v;
}
__device__ __forceinline__ float wave_max(float v) {
#pragma unroll
    for (int o = 1; o < 64; o <<= 1) v = fmaxf(v, __shfl_xor(v, o));
    return v;
}

#define XB_TMO      128
#define XB_XCNT(j)  (256  + 64 * (j))
#define XB_XSUB(j)  (1280 + 64 * (j))
#define XB_XGEN(j)  (2304 + 64 * (j))
#define XB_TOP      3328
#define XB_TOPGEN   3392
#define XCD_BAR_WORDS 3456
#define XB_SPIN_CAP (1u << 18)

__device__ __forceinline__ unsigned xb_ld(unsigned* p)              { return __hip_atomic_load(p, __ATOMIC_RELAXED, __HIP_MEMORY_SCOPE_AGENT); }
__device__ __forceinline__ unsigned xb_add(unsigned* p, unsigned v) { return __hip_atomic_fetch_add(p, v, __ATOMIC_RELAXED, __HIP_MEMORY_SCOPE_AGENT); }
__device__ __forceinline__ unsigned xb_xcc_id() { return (unsigned)__builtin_amdgcn_s_getreg((3 << 11) | 20) & 0xFu; }
#define XB_SPIN(cond, bar) do { unsigned _sp = 0; while (cond) { __builtin_amdgcn_s_sleep(1); \
    if ((++_sp & 255u) == 0u) { if (xb_ld(&(bar)[XB_TMO])) break; if (_sp > XB_SPIN_CAP) { atomicAdd(&(bar)[XB_TMO], 1u); break; } } } } while (0)

struct XcdBarrier {
    unsigned* bar; unsigned x;
    volatile LAS unsigned* st;
};

__device__ __forceinline__ XcdBarrier xcd_barrier_post(unsigned* bar, volatile LAS unsigned* st) {
    XcdBarrier b; b.bar = bar; b.x = xb_xcc_id(); b.st = st;
    if (threadIdx.x == 0) (void)xb_add(&bar[XB_XCNT(b.x)], 1u);
    return b;
}
__device__ __forceinline__ void xcd_barrier_complete(unsigned* bar, unsigned x, unsigned& nloc, unsigned& nx) {
    const unsigned G = gridDim.x * gridDim.y * gridDim.z;
    unsigned sum, cnt, mine, sp = 0u;
    for (;;) {
        sum = 0u; cnt = 0u; mine = 0u;
#pragma unroll
        for (unsigned j = 0; j < 16; ++j) { const unsigned c = xb_ld(&bar[XB_XCNT(j)]); sum += c; cnt += (c > 0u) ? 1u : 0u; mine = (j == x) ? c : mine; }
        if (sum == G) break;
        __builtin_amdgcn_s_sleep(1);
        if ((++sp & 255u) == 0u) { if (xb_ld(&bar[XB_TMO])) break; if (sp > XB_SPIN_CAP) { atomicAdd(&bar[XB_TMO], 1u); break; } }
    }
    nloc = mine > 0u ? mine : 1u; nx = cnt > 0u ? cnt : 1u;
}

__device__ __forceinline__ void xcd_barrier(const XcdBarrier& b) {
    asm volatile("s_waitcnt vmcnt(0)" ::: "memory");
    __syncthreads();
    if (threadIdx.x == 0) {
        unsigned* bar = b.bar;
        __builtin_amdgcn_s_waitcnt(0);
        unsigned nloc = b.st[0], nx = b.st[1];
        if (nloc == 0u) { xcd_barrier_complete(bar, b.x, nloc, nx); b.st[0] = nloc; b.st[1] = nx; }
        const unsigned old = xb_add(&bar[XB_XSUB(b.x)], 1u);
        const unsigned gen = old / nloc;
        if (old + 1u == (gen + 1u) * nloc) {
            __builtin_amdgcn_fence(__ATOMIC_RELEASE, "agent");
            asm volatile("s_waitcnt vmcnt(0)" ::: "memory");
            const unsigned og = xb_add(&bar[XB_TOP], 1u);
            const unsigned tg = og / nx;
            if (og + 1u == (tg + 1u) * nx) xb_add(&bar[XB_TOPGEN], 1u);
            else XB_SPIN(xb_ld(&bar[XB_TOPGEN]) == tg, bar);
            __builtin_amdgcn_fence(__ATOMIC_ACQUIRE, "agent");
            xb_add(&bar[XB_XGEN(b.x)], 1u);
            asm volatile("s_waitcnt vmcnt(0)" ::: "memory");
        } else {
            XB_SPIN(xb_ld(&bar[XB_XGEN(b.x)]) == gen, bar);
            __builtin_amdgcn_fence(__ATOMIC_ACQUIRE, "agent");
            asm volatile("s_waitcnt vmcnt(0)" ::: "memory");
        }
    }
    __syncthreads();
}

#ifdef DBG_CODES
#define DBGCHK(ws_, code, val) do { const float v__ = (val); if (!(fabsf(v__) < 1e30f)) atomicMax((unsigned*)((ws_) + 40960), 100u - (unsigned)(code)); } while (0)
#else
#define DBGCHK(ws_, code, val) do {} while (0)
#endif
struct Args { const float* in[26]; float* out; unsigned char* ws; int ph_lo, ph_hi; };

__device__ __forceinline__ void tr_block(const float* W, int ldw, int K, int c0, bf16* WT, int r0, int kb, const float* ks, int kmask, float mul, LAS float* scr, int lane) {
    const int k0 = 64 * kb;
#pragma unroll 8
    for (int i = 0; i < 32; ++i) { const int kk = 2 * i + (lane >> 5); float v = W[(size_t)(k0 + kk) * ldw + c0 + (lane & 31)]; if (ks) v *= ks[(k0 + kk) & kmask]; scr[kk * 33 + (lane & 31)] = v * mul; }
    asm volatile("s_waitcnt lgkmcnt(0)" ::: "memory");
    const int c = lane & 7;
#pragma unroll
    for (int j = 0; j < 4; ++j) { const int n = (lane >> 3) + 8 * j; const LAS float* s = scr + (8 * c) * 33 + n;
        v4u o; o.x = pkbf(s[0 * 33], s[1 * 33]); o.y = pkbf(s[2 * 33], s[3 * 33]); o.z = pkbf(s[4 * 33], s[5 * 33]); o.w = pkbf(s[6 * 33], s[7 * 33]);
        *(v4u*)(WT + (size_t)(r0 + n) * K + k0 + 8 * c) = o; }
    asm volatile("s_waitcnt lgkmcnt(0)" ::: "memory");
}
constexpr int IT_GU = 176 * 16, IT_DN = 32 * 44, IT_WIN = 256 * 16, IT_SQ = 32 * 16, IT_LAYER = 2 * IT_GU + 2 * IT_DN + IT_WIN + 3 * IT_SQ;
__device__ __forceinline__ void convert_item(const Args& a, int it, LAS float* scr, int lane) {
    const int l = it / IT_LAYER; int r = it % IT_LAYER;
    unsigned char* wb = a.ws + WS_W + (size_t)l * W_LSTRIDE;
    const float lam_init = 0.8f - 0.6f * expf(-0.3f * (float)l);
    for (int f = 0; f < 2; ++f) {
        const float* gu = a.in[f ? 23 : 2] + (size_t)l * DM * 2 * FF; const float* dn = a.in[f ? 24 : 3] + (size_t)l * FF * DM;
        if (r < IT_GU) { const int nb = r % 176, kb = r / 176, c0 = nb * 32, isu = c0 >= FF, fe = c0 - (isu ? FF : 0);
            tr_block(gu, 2 * FF, DM, c0, (bf16*)(wb + (f ? WO_GU2 : WO_GU1)), 256 * (fe >> 7) + 128 * isu + (fe & 127), kb, nullptr, 0, 1.f, scr, lane); return; } r -= IT_GU;
        if (r < IT_DN) { const int nb = r % 32, kb = r / 32; tr_block(dn, DM, FF, nb * 32, (bf16*)(wb + (f ? WO_DN2 : WO_DN1)), nb * 32, kb, nullptr, 0, 1.f, scr, lane); return; } r -= IT_DN;
    }
    if (r < IT_WIN) { const int nb = r % 256, kb = r / 256; const int c0 = nb < 192 ? nb * 32 : 6160 + (nb - 192) * 32;
        tr_block(a.in[6] + (size_t)l * DM * CIN, CIN, DM, c0, (bf16*)(wb + WO_WIN), nb * 32, kb, nullptr, 0, 1.f, scr, lane); return; } r -= IT_WIN;
    const int which = r / IT_SQ; r %= IT_SQ; const int nb = r % 32, kb = r / 32;
    if (which == 0) tr_block(a.in[17] + (size_t)l * DM * DM, DM, DM, nb * 32, (bf16*)(wb + WO_WA), nb * 32, kb, a.in[11] + l * 128, 127, 1.f - lam_init, scr, lane);
    else if (which == 1) tr_block(a.in[18] + (size_t)l * DM * DM, DM, DM, nb * 32, (bf16*)(wb + WO_WM), nb * 32, kb, a.in[16] + l * 1024, 1023, 1.f, scr, lane);
    else tr_block(a.in[20] + (size_t)l * DM * DM, DM, DM, nb * 32, (bf16*)(wb + WO_WO), nb * 32, kb, nullptr, 0, 1.f, scr, lane);
}

__device__ __forceinline__ void row_update(const float* xin, float* xout, const bf16* Y, float ysc, const float* wpost, const float* wnext, bf16* XN, size_t row, int lane) {
    const f32x4* xr = (const f32x4*)(xin + row * DM) + lane;
    f32x4 xv[4];
#pragma unroll
    for (int j = 0; j < 4; ++j) xv[j] = xr[64 * j];
    if (Y) {
        const v2u* yr = (const v2u*)(Y + row * DM) + lane; f32x4 yv[4]; float ss = 0.f;
#pragma unroll
        for (int j = 0; j < 4; ++j) { const v2u w = yr[64 * j]; yv[j] = (f32x4){bflo(w.x), bfhi(w.x), bflo(w.y), bfhi(w.y)}; ss += (yv[j].x * yv[j].x + yv[j].y * yv[j].y) + (yv[j].z * yv[j].z + yv[j].w * yv[j].w); }
        const float rs = ysc * rsqrtf(wave_sum(ss) * (1.f / DM) + EPS);
        f32x4* xo = (f32x4*)(xout + row * DM) + lane;
#pragma unroll
        for (int j = 0; j < 4; ++j) { const f32x4 wp = ((const f32x4*)wpost)[lane + 64 * j]; xv[j] = xv[j] + yv[j] * wp * rs;
#ifdef DBG_NANPROBE
            for (int e = 0; e < 4; ++e) if (!(fabsf(xv[j][e]) < 1e30f)) xv[j][e] = 100.f;
#endif
            xo[64 * j] = xv[j]; }
    }
    if (wnext) {
        float ss = 0.f;
#pragma unroll
        for (int j = 0; j < 4; ++j) ss += (xv[j].x * xv[j].x + xv[j].y * xv[j].y) + (xv[j].z * xv[j].z + xv[j].w * xv[j].w);
        const float rs = rsqrtf(wave_sum(ss) * (1.f / DM) + EPS);
        v2u* xo = (v2u*)(XN + row * DM) + lane;
#pragma unroll
        for (int j = 0; j < 4; ++j) { const f32x4 wn = ((const f32x4*)wnext)[lane + 64 * j]; const f32x4 h = xv[j] * wn * rs; v2u w; w.x = pkbf(h.x, h.y); w.y = pkbf(h.z, h.w); xo[64 * j] = w; }
    }
}
__device__ __forceinline__ void row_phase(const float* xin, float* xout, const bf16* Y, float ysc, const float* wpost, const float* wnext, bf16* XN,
                                          int row_lo, int nrows, const bf16* WGt, const float* igb, const float* fgb, float* GATES, int gw, int ngw, int lane) {
    for (int grp = gw; grp < nrows / 16; grp += ngw) {
        const size_t r0 = (size_t)row_lo + (size_t)grp * 16;
        for (int i = 0; i < 16; ++i) row_update(xin, xout, Y, ysc, wpost, wnext, XN, r0 + i, lane);
        if (WGt) {
            asm volatile("s_waitcnt vmcnt(0)" ::: "memory");
            __builtin_amdgcn_fence(__ATOMIC_ACQUIRE, "agent");
            const int fr = lane & 15, fq = lane >> 4;
            f32x4 acc = (f32x4){0.f, 0.f, 0.f, 0.f};
            const bf16* ap = XN + (r0 + fr) * DM + 8 * fq; const bf16* bp = WGt + fr * DM + 8 * fq;
#pragma unroll 8
            for (int ks = 0; ks < 32; ++ks) { const bf16x8 av = *(const bf16x8*)(ap + 32 * ks), bv = *(const bf16x8*)(bp + 32 * ks); acc = __builtin_amdgcn_mfma_f32_16x16x32_bf16(av, bv, acc, 0, 0, 0); }
            const float bias = fr < 8 ? igb[fr] : fgb[fr - 8];
#pragma unroll
            for (int i = 0; i < 4; ++i) GATES[(r0 + 4 * fq + i) * 16 + fr] = acc[i] + bias;
        }
    }
}

__device__ __forceinline__ void gates_phase(const bf16* XN, const bf16* WGt, const float* igb, const float* fgb, float* GATES, int row_lo, int nrows, int gw, int ngw, int lane) {
    const int fr = lane & 15, fq = lane >> 4;
    for (int grp = gw; grp < nrows / 16; grp += ngw) {
        const size_t r0 = (size_t)row_lo + (size_t)grp * 16;
        f32x4 acc = (f32x4){0.f, 0.f, 0.f, 0.f};
        const bf16* ap = XN + (r0 + fr) * DM + 8 * fq; const bf16* bp = WGt + fr * DM + 8 * fq;
#pragma unroll 8
        for (int ks = 0; ks < 32; ++ks) { const bf16x8 av = *(const bf16x8*)(ap + 32 * ks), bv = *(const bf16x8*)(bp + 32 * ks); acc = __builtin_amdgcn_mfma_f32_16x16x32_bf16(av, bv, acc, 0, 0, 0); }
        const float bias = fr < 8 ? igb[fr] : fgb[fr - 8];
#pragma unroll
        for (int i = 0; i < 4; ++i) GATES[(r0 + 4 * fq + i) * 16 + fr] = acc[i] + bias;
    }
}
__device__ __forceinline__ void gate_scan(const float* grow, int h, int lane, float& ig, float& bcum) {
    const float* g = grow + lane * 16; ig = g[h]; const float f = g[8 + h];
    float lf = fminf(f, 0.f) - log1pf(__expf(-fabsf(f)));
#pragma unroll
    for (int o = 1; o < 64; o <<= 1) { const float t = __shfl_up(lf, o); if (lane >= o) lf += t; }
    bcum = lf;
}
__device__ __forceinline__ void conv8(const bf16* MQK, size_t r0, int c, int ch, int rg, const float* cw, const float* cb, float (&out)[8]) {
    const float w0 = cw[ch], w1 = cw[1024 + ch], w2 = cw[2048 + ch], w3 = cw[3072 + ch], b = cb[ch];
    float x[11];
#pragma unroll
    for (int j = 0; j < 11; ++j) { const bool ok = !(c == 0 && rg == 0 && j < 3); x[j] = 0.f; if (ok) x[j] = bf2f(MQK[(r0 + rg * 8 + j - 3) * DM + ch]); }
#pragma unroll
    for (int i = 0; i < 8; ++i) { const float v = b + w0 * x[i] + w1 * x[i + 1] + w2 * x[i + 2] + w3 * x[i + 3]; out[i] = v * sigmf(v); }
}
constexpr int KP = 72, AP = 136;
__device__ __forceinline__ void m1_unit(LAS unsigned char* L, int u, const bf16* MQK, const bf16* MV, const float* GATESh, const float* cw, const float* cb,
                                        bf16* CST, float* NL, float* BLs, float* MLs, int tid, unsigned char* dws) {
    const int lane = tid & 63, wave = tid >> 6, fr = lane & 15, fq = lane >> 4;
    const int c = u & 63, bh = u >> 6, h = bh & 7, bl = bh >> 3; const size_t r0 = (size_t)bl * SEQ + c * 64;
    LAS float* WV = (LAS float*)L; LAS unsigned char* KT = L + 256; LAS unsigned char* VT = L + 256 + 64 * KP * 2;
    if (wave == 0) { float ig, bc; gate_scan(GATESh + r0 * 16, h, lane, ig, bc); DBGCHK(dws, 1, ig); DBGCHK(dws, 2, bc);
        const float blast = __shfl(bc, 63), a = blast - bc + ig, ml = wave_max(a); WV[lane] = __expf(a - ml); DBGCHK(dws, 3, WV[lane]);
        if (lane == 0) { BLs[u] = blast; MLs[u] = ml; } }
    __syncthreads();
    { const int d = tid & 63, rg = tid >> 6; float o[8]; conv8(MQK, r0, c, 512 + h * 64 + d, rg, cw, cb, o);
#pragma unroll
      for (int i = 0; i < 8; ++i) o[i] *= WV[rg * 8 + i];
      v4u w; w.x = pkbf(o[0], o[1]); w.y = pkbf(o[2], o[3]); w.z = pkbf(o[4], o[5]); w.w = pkbf(o[6], o[7]);
      *(LAS v4u*)(KT + d * (KP * 2) + rg * 16) = w; }
#pragma unroll
    for (int k = 0; k < 2; ++k) { const int t = tid + 512 * k, v = t & 127, rg = t >> 7; unsigned short e[8];
#pragma unroll
        for (int i = 0; i < 8; ++i) e[i] = MV[(r0 + rg * 8 + i) * DM + h * 128 + v];
        v4u w; w.x = e[0] | ((unsigned)e[1] << 16); w.y = e[2] | ((unsigned)e[3] << 16); w.z = e[4] | ((unsigned)e[5] << 16); w.w = e[6] | ((unsigned)e[7] << 16);
        *(LAS v4u*)(VT + v * (KP * 2) + rg * 16) = w; }
    __syncthreads();
    { bf16* ct = CST + (size_t)u * 8192;
#pragma unroll
      for (int j = 0; j < 4; ++j) { f32x4 acc = (f32x4){0.f, 0.f, 0.f, 0.f};
#pragma unroll
          for (int ks = 0; ks < 2; ++ks) { const bf16x8 af = *(const LAS bf16x8*)(KT + (16 * j + fr) * (KP * 2) + (32 * ks + 8 * fq) * 2), bf = *(const LAS bf16x8*)(VT + (16 * wave + fr) * (KP * 2) + (32 * ks + 8 * fq) * 2);
              acc = __builtin_amdgcn_mfma_f32_16x16x32_bf16(af, bf, acc, 0, 0, 0); }
          DBGCHK(dws, 4, acc[0] + acc[1] + acc[2] + acc[3]);
          v2u w; w.x = pkbf_c(acc[0], acc[1]); w.y = pkbf_c(acc[2], acc[3]);
          *(v2u*)(ct + (16 * wave + fr) * 64 + 16 * j + 4 * fq) = w; } }
    if (tid < 64) { float s = 0.f; const LAS bf16* kr = (const LAS bf16*)(KT + tid * (KP * 2));
#pragma unroll 8
        for (int l = 0; l < 64; ++l) s += bf2f(kr[l]);
        NL[(size_t)u * 64 + tid] = s; }
    __syncthreads();
}
__device__ __forceinline__ void m2_item(int item, unsigned* C32, float* NL, const float* BLs, const float* MLs, float* MP, int tid, unsigned char* dws) {
    const int bh = item >> 3, part = item & 7, e = part * 512 + tid; const int ub = bh * 64;
    float s0 = 0.f, s1 = 0.f, ns = 0.f, m = 0.f; const bool don = (part == 0 && tid < 64);
    for (int c0 = 0; c0 < 64; c0 += 8) {
        unsigned ld[8]; float nl[8];
#pragma unroll
        for (int i = 0; i < 8; ++i) { ld[i] = C32[(size_t)(ub + c0 + i) * 4096 + e]; nl[i] = don ? NL[(size_t)(ub + c0 + i) * 64 + tid] : 0.f; }
#pragma unroll
        for (int i = 0; i < 8; ++i) { const int u = ub + c0 + i; const float bl = BLs[u], ml = MLs[u];
            const float mn = fmaxf(bl + m, ml), sp = __expf(bl + m - mn), sl = __expf(ml - mn);
            DBGCHK(dws, 5, s0 + s1 + sp + sl);
            C32[(size_t)u * 4096 + e] = pkbf(s0, s1); s0 = sp * s0 + sl * bflo(ld[i]); s1 = sp * s1 + sl * bfhi(ld[i]);
            if (don) { NL[(size_t)u * 64 + tid] = ns; ns = sp * ns + sl * nl[i]; }
            if (part == 0 && tid == 0) MP[u] = m;
            m = mn; }
    }
}
__device__ __forceinline__ void m3_unit(LAS unsigned char* L, int u, const bf16* MQK, bf16* MV, const bf16* MO, const float* GATESh, const float* cw, const float* cb,
                                        const bf16* CST, const float* NL, const float* MP, int tid, unsigned char* dws) {
    const int lane = tid & 63, wave = tid >> 6, fr = lane & 15, fq = lane >> 4;
    const int c = u & 63, bh = u >> 6, h = bh & 7, bl = bh >> 3; const size_t r0 = (size_t)bl * SEQ + c * 64;
    LAS float* RT = (LAS float*)L; LAS float* SCI = RT + 64; LAS float* GS = RT + 128; LAS float* EMT = RT + 192; LAS float* NN = RT + 256; LAS float* DEN = RT + 384; LAS float* SSQ = RT + 448;
    LAS unsigned char* QC = L + 2304; LAS unsigned char* KC = QC + 64 * KP * 2; LAS unsigned char* AA = KC + 64 * KP * 2; LAS unsigned char* BB = AA + 64 * AP * 2;
    if (wave == 0) { float ig, bc; gate_scan(GATESh + r0 * 16, h, lane, ig, bc); const float g = ig - bc; float pm = g;
#pragma unroll
        for (int o = 1; o < 64; o <<= 1) { const float t = __shfl_up(pm, o); if (lane >= o) pm = fmaxf(pm, t); }
        const float mp = MP[u], mt = bc + fmaxf(mp, pm);
        RT[lane] = bc - mt; SCI[lane] = __expf(bc + mp - mt); GS[lane] = g; EMT[lane] = __expf(-mt); DBGCHK(dws, 6, mp); DBGCHK(dws, 7, EMT[lane] + SCI[lane] + RT[lane] + g); }
    if (wave == 1) { NN[lane] = NL[(size_t)u * 64 + lane]; NN[64 + lane] = 1.f; }
    { const int d = tid & 63, rg = tid >> 6; float o[8];
      conv8(MQK, r0, c, h * 64 + d, rg, cw, cb, o);
#pragma unroll
      for (int i = 0; i < 8; ++i) *(LAS bf16*)(QC + ((rg * 8 + i) * KP + d) * 2) = (bf16)(pkbf(o[i] * 0.125f, 0.f) & 0xffffu);
      conv8(MQK, r0, c, 512 + h * 64 + d, rg, cw, cb, o);
#pragma unroll
      for (int i = 0; i < 8; ++i) *(LAS bf16*)(KC + ((rg * 8 + i) * KP + d) * 2) = (bf16)(pkbf(o[i], 0.f) & 0xffffu); }
#pragma unroll
    for (int k = 0; k < 2; ++k) { const int t = tid + 512 * k, v = t & 127, rg = t >> 7; unsigned short e[8];
#pragma unroll
        for (int i = 0; i < 8; ++i) e[i] = MV[(r0 + rg * 8 + i) * DM + h * 128 + v];
        v4u w; w.x = e[0] | ((unsigned)e[1] << 16); w.y = e[2] | ((unsigned)e[3] << 16); w.z = e[4] | ((unsigned)e[5] << 16); w.w = e[6] | ((unsigned)e[7] << 16);
        *(LAS v4u*)(BB + v * (AP * 2) + (64 + rg * 8) * 2) = w; }
#pragma unroll
    for (int k = 0; k < 2; ++k) { const int t = tid + 512 * k, v = t >> 3, p = t & 7; *(LAS v4u*)(BB + v * (AP * 2) + p * 16) = *(const v4u*)(CST + (size_t)u * 8192 + v * 64 + p * 8); }
    __syncthreads();
    { const int lt = wave & 3;
      const int l = 16 * lt + fr; const float rt = RT[l];
#pragma unroll
      for (int q = 0; q < 2; ++q) { const int st = (wave >> 2) * 2 + q; f32x4 acc = (f32x4){0.f, 0.f, 0.f, 0.f};
#pragma unroll
          for (int ks = 0; ks < 2; ++ks) { const bf16x8 af = *(const LAS bf16x8*)(KC + (16 * st + fr) * (KP * 2) + (32 * ks + 8 * fq) * 2), bf = *(const LAS bf16x8*)(QC + (16 * lt + fr) * (KP * 2) + (32 * ks + 8 * fq) * 2);
              acc = __builtin_amdgcn_mfma_f32_16x16x32_bf16(af, bf, acc, 0, 0, 0); }
          float p[4];
#pragma unroll
          for (int i = 0; i < 4; ++i) { const int s = 16 * st + 4 * fq + i; p[i] = (s <= l) ? __expf(rt + GS[s]) * acc[i] : 0.f; }
          DBGCHK(dws, 8, p[0] + p[1] + p[2] + p[3]);
          v2u w; w.x = pkbf(p[0], p[1]); w.y = pkbf(p[2], p[3]); *(LAS v2u*)(AA + l * (AP * 2) + (64 + 16 * st + 4 * fq) * 2) = w; }
      const int l2 = tid >> 3, p8 = tid & 7; const float sc = SCI[l2]; const v4u qv = *(const LAS v4u*)(QC + l2 * (KP * 2) + p8 * 16); v4u o;
      o.x = pkbf(sc * bflo(qv.x), sc * bfhi(qv.x)); o.y = pkbf(sc * bflo(qv.y), sc * bfhi(qv.y)); o.z = pkbf(sc * bflo(qv.z), sc * bfhi(qv.z)); o.w = pkbf(sc * bflo(qv.w), sc * bfhi(qv.w));
      *(LAS v4u*)(AA + l2 * (AP * 2) + p8 * 16) = o; }
    __syncthreads();
    f32x4 acc[4];
    { const int lt = wave & 3;
#pragma unroll
      for (int i = 0; i < 8; ++i) { const int l = wave * 8 + i; const LAS bf16* ar = (const LAS bf16*)(AA + l * (AP * 2));
          const float s = wave_sum(bf2f(ar[lane]) * NN[lane] + bf2f(ar[64 + lane]) * NN[64 + lane]); if (lane == 0) DEN[l] = s; }
#pragma unroll
      for (int j = 0; j < 4; ++j) { const int vt = (wave >> 2) * 4 + j; acc[j] = (f32x4){0.f, 0.f, 0.f, 0.f};
#pragma unroll
          for (int ks = 0; ks < 4; ++ks) { const bf16x8 af = *(const LAS bf16x8*)(BB + (16 * vt + fr) * (AP * 2) + (32 * ks + 8 * fq) * 2), bf = *(const LAS bf16x8*)(AA + (16 * lt + fr) * (AP * 2) + (32 * ks + 8 * fq) * 2);
              acc[j] = __builtin_amdgcn_mfma_f32_16x16x32_bf16(af, bf, acc[j], 0, 0, 0); } } }
    __syncthreads();
    { const int lt = wave & 3, l = 16 * lt + fr; const float inv = 1.0f / fmaxf(fabsf(DEN[l]), EMT[l]); float ss = 0.f; DBGCHK(dws, 9, acc[0][0] + acc[1][1] + acc[2][2] + acc[3][3]); DBGCHK(dws, 10, DEN[l]); DBGCHK(dws, 11, inv);
#pragma unroll
      for (int j = 0; j < 4; ++j) { acc[j] = acc[j] * inv; ss += (acc[j][0] * acc[j][0] + acc[j][1] * acc[j][1]) + (acc[j][2] * acc[j][2] + acc[j][3] * acc[j][3]); }
      ss += __shfl_xor(ss, 16); ss += __shfl_xor(ss, 32);
      if (fq == 0) SSQ[l * 2 + (wave >> 2)] = ss; }
    __syncthreads();
    { const int lt = wave & 3, l = 16 * lt + fr; const float rs = rsqrtf((SSQ[l * 2] + SSQ[l * 2 + 1]) * (1.f / 128.f) + EPS);
#pragma unroll
      for (int j = 0; j < 4; ++j) { const int vt = (wave >> 2) * 4 + j; const size_t off = (r0 + l) * DM + h * 128 + 16 * vt + 4 * fq;
          const v2u mo = *(const v2u*)(MO + off); v2u w;
          DBGCHK(dws, 12, rs); DBGCHK(dws, 13, bflo(mo.x) + bfhi(mo.x) + bflo(mo.y) + bfhi(mo.y));
          w.x = pkbf(acc[j][0] * rs * sigmf(bflo(mo.x)), acc[j][1] * rs * sigmf(bfhi(mo.x))); w.y = pkbf(acc[j][2] * rs * sigmf(bflo(mo.y)), acc[j][3] * rs * sigmf(bfhi(mo.y)));
          *(v2u*)(MV + off) = w; } }
    __syncthreads();
}
__device__ __forceinline__ void ya_norm_row(bf16* YA, size_t row, int lane) {
    v4u* p = (v4u*)(YA + row * DM + 16 * lane); v4u a = p[0], b = p[1]; float f[16];
#pragma unroll
    for (int e = 0; e < 4; ++e) { f[2 * e] = bflo(a[e]); f[2 * e + 1] = bfhi(a[e]); f[8 + 2 * e] = bflo(b[e]); f[8 + 2 * e + 1] = bfhi(b[e]); }
    float ss = 0.f;
#pragma unroll
    for (int e = 0; e < 16; ++e) ss += f[e] * f[e];
    ss += __shfl_xor(ss, 1); ss += __shfl_xor(ss, 2); ss += __shfl_xor(ss, 4);
    const float rs = rsqrtf(ss * (1.f / 128.f) + EPS);
#pragma unroll
    for (int e = 0; e < 4; ++e) { a[e] = pkbf(f[2 * e] * rs, f[2 * e + 1] * rs); b[e] = pkbf(f[8 + 2 * e] * rs, f[8 + 2 * e + 1] * rs); }
    p[0] = a; p[1] = b;
}

#ifndef DBG_SKIP
#define DBG_SKIP 0
#endif
#ifndef MK_ONE_LAUNCH
#define MK_ONE_LAUNCH 1
#endif
constexpr int NPHASE = 1 + 20 * DEPTH;
__global__ void __launch_bounds__(NTHR, 2) mega_fwd(Args args) {
    extern __shared__ __attribute__((aligned(16))) unsigned char lds[];
    cg::grid_group grid = cg::this_grid();
    LAS unsigned char* L = (LAS unsigned char*)lds;
    const int G = gridDim.x, bx = blockIdx.x; const int vcu = (G % 8 == 0) ? (bx % 8) * (G / 8) + bx / 8 : bx;
    const int lo = args.ph_lo, hi = args.ph_hi;
    volatile LAS unsigned* MISC = (volatile LAS unsigned*)(L + RING_BYTES + 512);
    if (threadIdx.x < 64) MISC[threadIdx.x] = 0u;
    __syncthreads();
    XcdBarrier bar = xcd_barrier_post((unsigned*)(args.ws + 4096 * 4), MISC + 8);
    if (hi - lo > 1) grid.sync();
    for (int ph = lo; ph < hi; ++ph) {
            int tid_ = threadIdx.x; asm volatile("" : "+v"(tid_)); const int tid = tid_, lane = tid & 63, wave = __builtin_amdgcn_readfirstlane(tid >> 6), gw = bx * NWAVES + wave, ngw = G * NWAVES;
        int zz = 0; asm volatile("" : "+s"(zz));
            unsigned char* ws = args.ws + zz; float* const outp = args.out + zz;
        bf16* XN = (bf16*)(ws + WS_XN); float* GATES = (float*)(ws + WS_GATES); bf16* CST = (bf16*)(ws + WS_CST); float* NL = (float*)(ws + WS_NL);
        float* BLs = (float*)(ws + WS_BL); float* MLs = (float*)(ws + WS_ML); float* MPs = (float*)(ws + WS_MP);
        bf16* YA = (bf16*)(ws + WS_YA); bf16* ACT = (bf16*)(ws + WS_ACT); bf16* Y = (bf16*)(ws + WS_Y);
        bf16* AQ = (bf16*)(ws + WS_Z); bf16* AK = (bf16*)(ws + WS_Z + ZSTRIDE); bf16* AV = (bf16*)(ws + WS_Z + 2 * ZSTRIDE); bf16* MQK = (bf16*)(ws + WS_Z + 3 * ZSTRIDE);
        bf16* MV = (bf16*)(ws + WS_Z + 4 * ZSTRIDE); bf16* MO = (bf16*)(ws + WS_Z + 5 * ZSTRIDE); bf16* GLA = (bf16*)(ws + WS_Z + 6 * ZSTRIDE); bf16* GLM = (bf16*)(ws + WS_Z + 7 * ZSTRIDE);
        bf16* MERGED = AQ; bf16* YO = AK;
        if (ph == 0) {
            if (!(DBG_SKIP & 8)) { LAS float* scr = (LAS float*)(L + wave * 16384);
            for (int it = gw; it < DEPTH * IT_LAYER; it += ngw) convert_item(args, it, scr, lane);
            for (int i = bx * NTHR + tid; i < DEPTH * 16 * 1024; i += G * NTHR) { const int l = i >> 14, j = (i >> 10) & 15, k = i & 1023;
                ((bf16*)(ws + WS_WG))[i] = (bf16)(pkbf(args.in[(6) + zz][(size_t)l * DM * CIN + (size_t)k * CIN + 6144 + j], 0.f) & 0xffffu); }
            row_phase(args.in[(0) + zz], nullptr, nullptr, 0.f, nullptr, args.in[(1) + zz], XN, 0, M, nullptr, nullptr, nullptr, nullptr, gw, ngw, lane); }
        } else {
            const int l = (ph - 1) / 20, p = (ph - 1) % 20;
            unsigned char* wb = ws + WS_W + (size_t)l * W_LSTRIDE;
            if ((p == 0 || p == 17)) {  if (!(DBG_SKIP & 1)) {
                pg8::Gemm g{XN, (const bf16*)(wb + (p == 0 ? WO_GU1 : WO_GU2)), M, 2 * FF, DM}; pg8::StaticOrder S; S.init(M, 2 * FF, G, bx);
                pg8::EpiSwiglu E{ACT, FF};
                pg8::gemm_phase<pg8::EpiSwiglu, pg8::StaticOrder, PG8_ALIGN, PG8_SP2>(L, g, S, E); }
            } else if (p == 1 || p == 18 || p == 3 || p == 10 || p == 8 || p == 15) {
                if (!(DBG_SKIP & 1)) { pg8::Gemm g; pg8::StaticOrder S; pg8::EpiBf16<0> E;
                if (p == 1 || p == 18) { g = pg8::Gemm{ACT, (const bf16*)(wb + (p == 1 ? WO_DN1 : WO_DN2)), M, DM, FF}; S.init(M, DM, G, bx); E = pg8::EpiBf16<0>{Y, DM, nullptr, 0, 0, 1.f}; }
                else if (p == 3 || p == 10) { const int hb = (p == 10);
                    gates_phase(XN, (const bf16*)(ws + WS_WG) + (size_t)l * 16 * DM, args.in[(14) + zz] + l * 8, args.in[(15) + zz] + l * 8, GATES, hb * MH, MH, gw, ngw, lane);
                    g = pg8::Gemm{XN + (size_t)hb * MH * DM, (const bf16*)(wb + WO_WIN), MH, 8192, DM}; S.init(MH, 8192, G, bx);
                    E = pg8::EpiBf16<0>{AQ, DM, nullptr, DM, ZSTRIDE / 2, attn_body::C2}; }
                else { g = pg8::Gemm{MERGED, (const bf16*)(wb + WO_WO), MH, DM, DM}; S.init(MH, DM, G, bx); E = pg8::EpiBf16<0>{YO, DM, nullptr, 0, 0, 1.f}; }
                pg8::gemm_phase<pg8::EpiBf16<0>, pg8::StaticOrder, PG8_ALIGN, PG8_SP2>(L, g, S, E); }
            } else if (p == 2 || p == 19 || p == 9 || p == 16) {    if (!(DBG_SKIP & 8)) {
                if (p == 2) row_phase(l == 0 ? args.in[(0) + zz] : outp, outp, Y, 0.5f, args.in[(4) + zz] + l * DM, args.in[(5) + zz] + l * DM, XN, 0, M,
                                      nullptr, nullptr, nullptr, nullptr, gw, ngw, lane);
                else if (p == 19) row_phase(outp, outp, Y, 0.5f, args.in[(25) + zz] + l * DM, (l + 1 < DEPTH) ? args.in[(1) + zz] + (l + 1) * DM : nullptr, XN, 0, M, nullptr, nullptr, nullptr, nullptr, gw, ngw, lane);
                else { const int hb = (p == 16); row_phase(outp, outp, YO - (size_t)hb * MH * DM, 1.0f, args.in[(21) + zz] + l * DM, args.in[(22) + zz] + l * DM, XN, hb * MH, MH, nullptr, nullptr, nullptr, nullptr, gw, ngw, lane); } }
            } else {
                const int hb = (p >= 10), q = p - (hb ? 10 : 3);
                const float* GATESh = GATES + (size_t)hb * MH * 16; const float* cw = args.in[(12) + zz] + l * 4 * 1024; const float* cb = args.in[(13) + zz] + l * 1024;
                if (q == 1) {
                    if (!(DBG_SKIP & 4)) for (int u = bx; u < 2048; u += G) m1_unit(L, u, MQK, MV, GATESh, cw, cb, CST, NL, BLs, MLs, tid, ws);
                    const float lam_init = 0.8f - 0.6f * expf(-0.3f * (float)l); float d1 = 0.f, d2 = 0.f;
                    for (int i = 0; i < 64; ++i) { d1 += args.in[(7) + zz][l * 64 + i] * args.in[(8) + zz][l * 64 + i]; d2 += args.in[(9) + zz][l * 64 + i] * args.in[(10) + zz][l * 64 + i]; }
                    const float lam = expf(d1) - expf(d2) + lam_init;
                    const int nun = (G == 256) ? 4 : (1024 - bx + G - 1) / G;
                    if (!(DBG_SKIP & 2))
                    for (int i2 = 0; i2 < 2 * nun; ++i2) { const int i = i2 >> 1, pass = i2 & 1; int combo, qb;
                        if (G == 256) { const int s = vcu & 3; combo = vcu >> 2; qb = (i == 0) ? 15 - s : (i == 1) ? 8 + s : (i == 2) ? 7 - s : s; }
                        else { const int uu = bx + i * G; combo = uu >> 4; qb = uu & 15; }
                        const int vh = combo & 1, h = (combo >> 1) & 7, bl = combo >> 4;
                        attn_body::attn_unit<8>(bl, 2 * h + pass, 2 * h + vh, qb, (const attn_body::bf16*)AQ, (const attn_body::bf16*)AK, (const attn_body::bf16*)AV, (attn_body::bf16*)YA, (char*)lds, pass, lam); }
                } else if (q == 2) {
                    if (!(DBG_SKIP & 4)) for (int it = bx; it < 256; it += G) m2_item(it, (unsigned*)CST, NL, BLs, MLs, MPs, tid, ws);
                } else if (q == 3) {
                    if (!(DBG_SKIP & 4)) for (int u = bx; u < 2048; u += G) m3_unit(L, u, MQK, MV, MO, GATESh, cw, cb, CST, NL, MPs, tid, ws);
                    for (int r = gw; r < MH; r += ngw) ya_norm_row(YA, (size_t)r, lane);
                } else {
                    if (!(DBG_SKIP & 16)) { pg8::StaticOrder S; S.init(MH, DM, G, bx);
                    { pg8::Gemm g{YA, (const bf16*)(wb + WO_WA), MH, DM, DM}; pg8::EpiMerge<0> E{MERGED, GLA, args.in[(19) + zz] + l * 2 * DM};
                      pg8::gemm_phase<pg8::EpiMerge<0>, pg8::StaticOrder, PG8_ALIGN, PG8_SP2>(L, g, S, E); }
                    { pg8::Gemm g{MV, (const bf16*)(wb + WO_WM), MH, DM, DM}; pg8::EpiMerge<1> E{MERGED, GLM, args.in[(19) + zz] + l * 2 * DM + DM};
                      pg8::gemm_phase<pg8::EpiMerge<1>, pg8::StaticOrder, PG8_ALIGN, PG8_SP2>(L, g, S, E); } }
                }
            }
        }
        if (ph + 1 < hi) xcd_barrier(bar);
    }
#ifdef DBG_CODES
    if (blockIdx.x == 0 && threadIdx.x == 0) { asm volatile("s_waitcnt vmcnt(0)" ::: "memory"); const unsigned d = __hip_atomic_load((unsigned*)(args.ws + 40960), __ATOMIC_RELAXED, __HIP_MEMORY_SCOPE_AGENT); if (d) args.out[0] = 1000.f * (float)(100u - d); }
#endif
}

extern "C" void kernel_launch(void* const* d_in, const int* in_sizes, int n_in, void* d_out, int out_size, void* d_ws, size_t ws_size, hipStream_t stream) {
    static int grid = 0;
    if (grid == 0) {
        if (n_in != 26 || in_sizes[0] != M * DM || out_size != M * DM || ws_size < WS_END) { fprintf(stderr, "kernel_launch: unexpected shapes: n_in %d in0 %d out %d ws %zu\n", n_in, n_in > 0 ? in_sizes[0] : -1, out_size, ws_size); grid = -1; return; }
        int dev = 0, cus = 0, per_cu = 0;
        hipGetDevice(&dev); hipDeviceGetAttribute(&cus, hipDeviceAttributeMultiprocessorCount, dev);
        if (hipFuncSetAttribute((const void*)mega_fwd, hipFuncAttributeMaxDynamicSharedMemorySize, LDS_BYTES) != hipSuccess) { fprintf(stderr, "kernel_launch: hipFuncSetAttribute failed\n"); grid = -1; return; }
        if (hipOccupancyMaxActiveBlocksPerMultiprocessor(&per_cu, (const void*)mega_fwd, NTHR, LDS_BYTES) != hipSuccess || per_cu < 1) { fprintf(stderr, "kernel_launch: occupancy query says %d\n", per_cu); per_cu = 1; }
        (void)hipGetLastError();
        grid = cus * per_cu;
    }
    if (grid < 0) return;
    if (hipMemsetAsync(d_ws, 0, 65536, stream) != hipSuccess) { fprintf(stderr, "kernel_launch: memset failed\n"); return; }
    Args a{};
    for (int i = 0; i < 26; ++i) a.in[i] = (const float*)d_in[i];
    a.out = (float*)d_out; a.ws = (unsigned char*)d_ws;
#if MK_ONE_LAUNCH
#ifdef DBG_HI
    a.ph_lo = 0; a.ph_hi = DBG_HI;
#else
    a.ph_lo = 0; a.ph_hi = NPHASE;
#endif
    void* kargs[] = {&a};
    hipError_t e = hipLaunchCooperativeKernel((const void*)mega_fwd, dim3(grid), dim3(NTHR), kargs, LDS_BYTES, stream);
    if (e != hipSuccess) fprintf(stderr, "kernel_launch: cooperative launch failed: %s (grid %d)\n", hipGetErrorString(e), grid);
#else
    for (int ph = 0; ph < NPHASE; ++ph) { a.ph_lo = ph; a.ph_hi = ph + 1; hipLaunchKernelGGL(mega_fwd, dim3(grid), dim3(NTHR), LDS_BYTES, stream, a); }
#endif
}
```

```cpp
#include <hip/hip_runtime.h>
#include <cstdio>
#include <cstdint>
namespace pg8 {
#define PG8_LAS __attribute__((address_space(3)))
typedef unsigned short bf16_t;
typedef short bf16x8 __attribute__((ext_vector_type(8)));
typedef float f32x4 __attribute__((ext_vector_type(4)));
typedef unsigned u32x4 __attribute__((ext_vector_type(4)));
constexpr int BM = 256, BK = 64, HALF = 128, HTB = HALF * BK * 2  , STAGE_BYTES = 8 * HTB, NXCD = 8, WGM = 8;

__host__ __device__ __forceinline__ int lds_byte(int r, int c) { const int st = (r >> 4) * 2 + (c >> 5), rr = r & 15, cc = c & 31, ob = rr * 64 + cc * 2; return st * 1024 + (ob ^ (((ob >> 9) & 1) << 5)); }
__host__ __device__ __forceinline__ void stage_rc(int b, int& R, int& C) { const int st = b / 1024, sb = b % 1024, swz = sb ^ (((sb >> 9) & 1) << 5); R = (st >> 1) * 16 + swz / 64; C = (st & 1) * 32 + (swz % 64) / 2; }
__host__ __device__ __forceinline__ int perm32(int rho) { const int n = rho >> 4, i = rho & 15; return 8 * (i >> 2) + 4 * n + (i & 3); }

struct Unit { int pm, pn; };
struct Gemm { const bf16_t* A; const bf16_t* Bt; int M, N, K; };

struct StaticOrder {
    int nM, nN, nwg, G, c;
    __host__ __device__ void init(int M, int N, int G_, int c_) { nM = M / BM; nN = N / BM; nwg = nM * nN; G = G_; c = c_; }
    __host__ __device__ bool next(int i, Unit& u) const {
        const long L = (long)i * G + c; if (L >= nwg) return false;
        int wgid = (int)L; { const int q = nwg / NXCD, r = nwg % NXCD, xcd = wgid % NXCD, off = wgid / NXCD; wgid = (xcd < r ? xcd * (q + 1) : r * (q + 1) + (xcd - r) * q) + off; }
        const int nig = WGM * nN, gid = wgid / nig, fm = gid * WGM, gsz = (nM - fm) < WGM ? (nM - fm) : WGM;
        u.pm = fm + ((wgid % nig) % gsz); u.pn = (wgid % nig) / gsz; return true;
    }
    __device__ __forceinline__ void a_ready(const Unit&) const {}
    __device__ __forceinline__ void done(const Unit&) const {}
};

__device__ __forceinline__ unsigned cvt_pk_bf16(float lo, float hi) { unsigned r; asm volatile("v_cvt_pk_bf16_f32 %0, %1, %2" : "=v"(r) : "v"(lo), "v"(hi)); return r; }
typedef float f32x2 __attribute__((ext_vector_type(2)));
__device__ __forceinline__ f32x2 gelu_pk(f32x2 v) {
    const f32x2 av = __builtin_elementwise_abs(v), d = av * 0.2316418882f + 1.0f;
    f32x2 t; t.x = __builtin_amdgcn_rcpf(d.x); t.y = __builtin_amdgcn_rcpf(d.y);
    f32x2 q = t * 0.5307027145f + (-0.7265760135f); q = q * t + 0.7107068705f; q = q * t + (-0.142248368f); q = q * t + 0.127414796f; q = q * t;
    const f32x2 s = (v * v) * (-0.72134752044f);
    f32x2 e; e.x = __builtin_amdgcn_exp2f(s.x); e.y = __builtin_amdgcn_exp2f(s.y);
    const f32x2 m = v * (q * e), r = v - m;
    f32x2 o; o.x = v.x < 0.f ? m.x : r.x; o.y = v.y < 0.f ? m.y : r.y; return o;
}

template <int ACT  > struct EpiBf16 {
    static constexpr bool PERM = true, AFTER_DRAIN = false; static_assert(ACT == 0 || ACT == 1, "EpiBf16: ACT is 0 (none) or 1 (gelu_pk)");
    bf16_t* O; int ldc; const float* bias; int split_cols; size_t split_stride; float scale0;
    __device__ __forceinline__ void operator()(const f32x4 (&acc)[2][2][4][2], const Unit& u, int wr, int wc, int fr, int fq) const {
        const int row0 = u.pm * BM + wr * 64 + fr; int colt = u.pn * BM; bf16_t* base = O;
        float sc = 1.f; if (split_cols) { const int t = colt / split_cols; base += (size_t)t * split_stride; colt -= t * split_cols; if (t == 0) sc = scale0; }
        const int col0 = colt + wc * 32 + 8 * fq, bcol0 = u.pn * BM + wc * 32 + 8 * fq;
        f32x4 bv[2][2];
#pragma unroll
        for (int bj = 0; bj < 2; ++bj)
#pragma unroll
            for (int n = 0; n < 2; ++n) bv[bj][n] = bias ? *(const f32x4*)(bias + bcol0 + bj * HALF + 4 * n) : (f32x4){0.f, 0.f, 0.f, 0.f};
#pragma unroll
        for (int ai = 0; ai < 2; ++ai)
#pragma unroll
            for (int m = 0; m < 4; ++m) { bf16_t* rowp = base + (size_t)(row0 + ai * HALF + m * 16) * ldc + col0;
#pragma unroll
                for (int bj = 0; bj < 2; ++bj) { f32x4 v0 = acc[ai][bj][m][0] + bv[bj][0], v1 = acc[ai][bj][m][1] + bv[bj][1];
                    if (ACT == 1) { f32x2 a = gelu_pk((f32x2){v0[0], v0[1]}), b = gelu_pk((f32x2){v0[2], v0[3]}), c = gelu_pk((f32x2){v1[0], v1[1]}), d = gelu_pk((f32x2){v1[2], v1[3]});
                        v0 = (f32x4){a.x, a.y, b.x, b.y}; v1 = (f32x4){c.x, c.y, d.x, d.y}; }
                    v0 = v0 * sc; v1 = v1 * sc; u32x4 w; w.x = cvt_pk_bf16(v0[0], v0[1]); w.y = cvt_pk_bf16(v0[2], v0[3]); w.z = cvt_pk_bf16(v1[0], v1[1]); w.w = cvt_pk_bf16(v1[2], v1[3]);
                    *(u32x4*)(rowp + bj * HALF) = w; } }
    }
};
__device__ __forceinline__ float bflo(unsigned w) { return __uint_as_float(w << 16); }
__device__ __forceinline__ float bfhi(unsigned w) { return __uint_as_float(w & 0xffff0000u); }
__device__ __forceinline__ float sigm(float x) { return __builtin_amdgcn_rcpf(1.0f + __builtin_amdgcn_exp2f(-1.4426950408889634f * x)); }
struct EpiSwiglu {
    static constexpr bool PERM = true, AFTER_DRAIN = false;
    bf16_t* O; int ldc;
    __device__ __forceinline__ void operator()(const f32x4 (&acc)[2][2][4][2], const Unit& u, int wr, int wc, int fr, int fq) const {
        const int row0 = u.pm * BM + wr * 64 + fr, col0 = u.pn * HALF + wc * 32 + 8 * fq;
#pragma unroll
        for (int ai = 0; ai < 2; ++ai)
#pragma unroll
            for (int m = 0; m < 4; ++m) { bf16_t* rowp = O + (size_t)(row0 + ai * HALF + m * 16) * ldc + col0;
                float r[8];
#pragma unroll
                for (int n = 0; n < 2; ++n)
#pragma unroll
                    for (int e = 0; e < 4; ++e) { const float g = acc[ai][0][m][n][e], uu = acc[ai][1][m][n][e]; r[n * 4 + e] = g * sigm(g) * uu; }
                u32x4 w; w.x = cvt_pk_bf16(r[0], r[1]); w.y = cvt_pk_bf16(r[2], r[3]); w.z = cvt_pk_bf16(r[4], r[5]); w.w = cvt_pk_bf16(r[6], r[7]);
                *(u32x4*)rowp = w; }
    }
};
template <int MODE> struct EpiMerge {
    static constexpr bool PERM = true, AFTER_DRAIN = false;
    bf16_t* O; const bf16_t* GL; const float* gb;
    __device__ __forceinline__ void operator()(const f32x4 (&acc)[2][2][4][2], const Unit& u, int wr, int wc, int fr, int fq) const {
        const int row0 = u.pm * BM + wr * 64 + fr, col0 = u.pn * BM + wc * 32 + 8 * fq;
        f32x4 bv[2][2];
#pragma unroll
        for (int bj = 0; bj < 2; ++bj)
#pragma unroll
            for (int n = 0; n < 2; ++n) bv[bj][n] = *(const f32x4*)(gb + col0 + bj * HALF + 4 * n);
#pragma unroll
        for (int ai = 0; ai < 2; ++ai)
#pragma unroll
            for (int m = 0; m < 4; ++m) { const size_t off = (size_t)(row0 + ai * HALF + m * 16) * 1024 + col0;
#pragma unroll
                for (int bj = 0; bj < 2; ++bj) { const u32x4 gw = *(const u32x4*)(GL + off + bj * HALF);
                    u32x4 ow = (u32x4){0u, 0u, 0u, 0u}; if (MODE == 1) ow = *(const u32x4*)(O + off + bj * HALF);
                    float r[8];
#pragma unroll
                    for (int e = 0; e < 4; ++e) { const int n = e >> 1, c = (e & 1) * 2;
                        float v0 = acc[ai][bj][m][n][c] * sigm(bflo(gw[e]) + bv[bj][n][c]), v1 = acc[ai][bj][m][n][c + 1] * sigm(bfhi(gw[e]) + bv[bj][n][c + 1]);
                        if (MODE == 1) { v0 += bflo(ow[e]); v1 += bfhi(ow[e]); }
                        r[2 * e] = v0; r[2 * e + 1] = v1; }
                    u32x4 w; w.x = cvt_pk_bf16(r[0], r[1]); w.y = cvt_pk_bf16(r[2], r[3]); w.z = cvt_pk_bf16(r[4], r[5]); w.w = cvt_pk_bf16(r[6], r[7]);
                    *(u32x4*)(O + off + bj * HALF) = w; } }
    }
};
template <class Epi, class Sched, bool ALIGN_EPI = false, bool SP2 = false>
__device__ __forceinline__ void gemm_phase(PG8_LAS unsigned char* lds, const Gemm g, const Sched& S, const Epi& E) {
    int tid_ = threadIdx.x; asm volatile("" : "+v"(tid_));
    const int tid = tid_, wid = __builtin_amdgcn_readfirstlane(tid >> 6), lane = tid & 63, wr = wid >> 2, wc = wid & 3, fr = lane & 15, fq = lane >> 4;
    const int K = g.K, nt = K / BK;
    unsigned voffA[2], voffB[2];
#pragma unroll
    for (int i = 0; i < 2; ++i) { int R, C; stage_rc(tid * 16 + i * 8192, R, C); const int Rb = Epi::PERM ? ((R & ~31) + perm32(R & 31)) : R;
        voffA[i] = (unsigned)(R * K + C) * 2u; voffB[i] = (unsigned)(Rb * K + C) * 2u; }
    const size_t kstep = (size_t)(BK * 2);
    const size_t hstep = (size_t)HALF * K * 2;
    const size_t tstep = 2 * hstep;
    const unsigned ldsw = (unsigned)wid * 1024u;
    const int aoff = lds_byte(wr * 64 + fr, fq * 8), boff = lds_byte(wc * 32 + fr, fq * 8);
#define PG8_SA(b, h) (((b) * 2 + (h)) * HTB)
#define PG8_SB(b, h) ((4 + (b) * 2 + (h)) * HTB)
#define PG8_STAGE(bufoff, gbase, voff) do { _Pragma("unroll") for (int _i = 0; _i < 2; ++_i) \
        __builtin_amdgcn_global_load_lds((const unsigned*)((const char*)(gbase) + (voff)[_i]), (PG8_LAS unsigned*)(lds + (bufoff) + ldsw + _i * 8192), 16, 0, 0); } while (0)
#define PG8_LDA(dst, b, h) do { _Pragma("unroll") for (int m = 0; m < 4; ++m) _Pragma("unroll") for (int k = 0; k < 2; ++k) dst[m][k] = *(const PG8_LAS bf16x8*)(lds + PG8_SA(b, h) + aoff + m * 2048 + k * 1024); } while (0)
#define PG8_LDB(dst, b, h) do { _Pragma("unroll") for (int n = 0; n < 2; ++n) _Pragma("unroll") for (int k = 0; k < 2; ++k) dst[n][k] = *(const PG8_LAS bf16x8*)(lds + PG8_SB(b, h) + boff + n * 2048 + k * 1024); } while (0)
#define PG8_MMA(ai, bj, At, Bt) do { __builtin_amdgcn_s_setprio(1); _Pragma("unroll") for (int m = 0; m < 4; ++m) _Pragma("unroll") for (int n = 0; n < 2; ++n) _Pragma("unroll") for (int k = 0; k < 2; ++k) \
        acc[ai][bj][m][n] = __builtin_amdgcn_mfma_f32_16x16x32_bf16(Bt[n][k], At[m][k], acc[ai][bj][m][n], 0, 0, 0); __builtin_amdgcn_s_setprio(0); } while (0)
#define PG8_WAIT_V(n) asm volatile("s_waitcnt vmcnt(" #n ")" ::: "memory")
#define PG8_WAIT_L(n) asm volatile("s_waitcnt lgkmcnt(" #n ")" ::: "memory")
#define PG8_BAR __builtin_amdgcn_s_barrier()
#define PG8_SCHED __builtin_amdgcn_sched_barrier(0)
    Unit cur, nxt; int ui = 0;
    if (!S.next(0, cur)) return;
    f32x4 acc[2][2][4][2];
#pragma unroll
    for (int a = 0; a < 2; ++a)
#pragma unroll
        for (int b = 0; b < 2; ++b)
#pragma unroll
            for (int m = 0; m < 4; ++m)
#pragma unroll
                for (int n = 0; n < 2; ++n) acc[a][b][m][n] = (f32x4){0.f, 0.f, 0.f, 0.f};
    bf16x8 At[4][2], B0[2][2], B1[2][2];
    const char* cA = (const char*)g.A + (size_t)cur.pm * tstep; const char* cB = (const char*)g.Bt + (size_t)cur.pn * tstep;
    S.a_ready(cur);
    if constexpr (SP2) {
        PG8_STAGE(PG8_SB(0, 0), cB, voffB); PG8_STAGE(PG8_SB(0, 1), cB + hstep, voffB); PG8_STAGE(PG8_SA(0, 0), cA, voffA); PG8_STAGE(PG8_SA(0, 1), cA + hstep, voffA);
        if (wr == 1) PG8_BAR;
        PG8_WAIT_V(2); PG8_BAR;
        PG8_STAGE(PG8_SB(1, 0), cB + kstep, voffB); PG8_STAGE(PG8_SA(1, 0), cA + kstep, voffA); PG8_STAGE(PG8_SB(1, 1), cB + hstep + kstep, voffB);
        PG8_WAIT_V(6); PG8_BAR;
    } else {
        PG8_STAGE(PG8_SB(0, 0), cB, voffB); PG8_STAGE(PG8_SA(0, 0), cA, voffA); PG8_STAGE(PG8_SB(0, 1), cB + hstep, voffB); PG8_STAGE(PG8_SA(0, 1), cA + hstep, voffA);
        if (wr == 1) PG8_BAR;
        PG8_WAIT_V(4); PG8_BAR;
        PG8_STAGE(PG8_SB(1, 0), cB + kstep, voffB); PG8_STAGE(PG8_SA(1, 0), cA + kstep, voffA); PG8_STAGE(PG8_SB(1, 1), cB + hstep + kstep, voffB);
        PG8_WAIT_V(6); PG8_BAR;
    }
    for (;;) {
        const bool has_next = S.next(ui + 1, nxt);
        const char* nA = has_next ? (const char*)g.A + (size_t)nxt.pm * tstep : cA; const char* nB = has_next ? (const char*)g.Bt + (size_t)nxt.pn * tstep : cB;
        for (int t = 0; t < nt; t += 2) {
            const bool last = (t == nt - 2);
            const char* a1 = cA + (size_t)(t + 1) * kstep;
            const char* a2 = last ? nA : cA + (size_t)(t + 2) * kstep; const char* b2 = last ? nB : cB + (size_t)(t + 2) * kstep;
            const char* a3 = a2 + kstep; const char* b3 = b2 + kstep;
            if (last && has_next) S.a_ready(nxt);
            if constexpr (SP2) {
            PG8_LDB(B0, 0, 0); PG8_LDB(B1, 0, 1); PG8_SCHED; PG8_LDA(At, 0, 0); PG8_STAGE(PG8_SA(1, 1), a1 + hstep, voffA);
            PG8_WAIT_V(8); PG8_WAIT_L(0); PG8_BAR; PG8_MMA(0, 0, At, B0); PG8_MMA(0, 1, At, B1); PG8_BAR; PG8_SCHED;
            PG8_LDA(At, 0, 1); PG8_STAGE(PG8_SB(0, 0), b2, voffB); PG8_STAGE(PG8_SB(0, 1), b2 + hstep, voffB); PG8_STAGE(PG8_SA(0, 0), a2, voffA);
            PG8_WAIT_V(8); PG8_WAIT_L(0); PG8_BAR; PG8_MMA(1, 0, At, B0); PG8_MMA(1, 1, At, B1); PG8_BAR; PG8_SCHED;
            PG8_LDB(B0, 1, 0); PG8_LDB(B1, 1, 1); PG8_SCHED; PG8_LDA(At, 1, 0); PG8_STAGE(PG8_SA(0, 1), a2 + hstep, voffA);
            PG8_WAIT_V(8); PG8_WAIT_L(0); PG8_BAR; PG8_MMA(0, 0, At, B0); PG8_MMA(0, 1, At, B1); PG8_BAR; PG8_SCHED;
            PG8_LDA(At, 1, 1); PG8_STAGE(PG8_SB(1, 0), b3, voffB); PG8_STAGE(PG8_SB(1, 1), b3 + hstep, voffB); PG8_STAGE(PG8_SA(1, 0), a3, voffA);
            PG8_WAIT_V(8); PG8_WAIT_L(0); PG8_BAR; PG8_MMA(1, 0, At, B0); PG8_MMA(1, 1, At, B1); PG8_BAR; PG8_SCHED;
            } else {
            PG8_LDB(B0, 0, 0); PG8_SCHED; PG8_LDA(At, 0, 0); PG8_STAGE(PG8_SA(1, 1), a1 + hstep, voffA);
            PG8_WAIT_L(8); PG8_BAR; PG8_WAIT_L(0); PG8_MMA(0, 0, At, B0); PG8_BAR; PG8_SCHED;
            PG8_LDB(B1, 0, 1); PG8_STAGE(PG8_SB(0, 0), b2, voffB);
            PG8_BAR; PG8_WAIT_L(0); PG8_MMA(0, 1, At, B1); PG8_BAR;
            PG8_LDA(At, 0, 1); PG8_STAGE(PG8_SA(0, 0), a2, voffA);
            PG8_BAR; PG8_WAIT_L(0); PG8_MMA(1, 0, At, B0); PG8_BAR; PG8_SCHED;
            PG8_STAGE(PG8_SB(0, 1), b2 + hstep, voffB);
            PG8_WAIT_V(6); PG8_BAR; PG8_MMA(1, 1, At, B1); PG8_BAR;
            PG8_LDB(B0, 1, 0); PG8_SCHED; PG8_LDA(At, 1, 0); PG8_STAGE(PG8_SA(0, 1), a2 + hstep, voffA);
            PG8_WAIT_L(8); PG8_BAR; PG8_WAIT_L(0); PG8_MMA(0, 0, At, B0); PG8_BAR; PG8_SCHED;
            PG8_LDB(B1, 1, 1); PG8_STAGE(PG8_SB(1, 0), b3, voffB);
            PG8_BAR; PG8_WAIT_L(0); PG8_MMA(0, 1, At, B1); PG8_BAR;
            PG8_LDA(At, 1, 1); PG8_STAGE(PG8_SA(1, 0), a3, voffA);
            PG8_BAR; PG8_WAIT_L(0); PG8_MMA(1, 0, At, B0); PG8_BAR; PG8_SCHED;
            PG8_STAGE(PG8_SB(1, 1), b3 + hstep, voffB);
            PG8_WAIT_V(6); PG8_BAR; PG8_MMA(1, 1, At, B1); PG8_BAR;
            }
        }
        if constexpr (ALIGN_EPI) { if (wr == 0) PG8_BAR; }
        if constexpr (!Epi::AFTER_DRAIN) { E(acc, cur, wr, wc, fr, fq); S.done(cur); }
        if (!has_next) break;
#pragma unroll
        for (int a = 0; a < 2; ++a)
#pragma unroll
            for (int b = 0; b < 2; ++b)
#pragma unroll
                for (int m = 0; m < 4; ++m)
#pragma unroll
                    for (int n = 0; n < 2; ++n) acc[a][b][m][n] = (f32x4){0.f, 0.f, 0.f, 0.f};
        cur = nxt; cA = nA; cB = nB; ++ui;
        if constexpr (ALIGN_EPI) { if (wr == 1) PG8_BAR; }
    }
    PG8_WAIT_V(0);
    if constexpr (!ALIGN_EPI) { if (wr == 0) PG8_BAR; }
    PG8_BAR;
    if constexpr (Epi::AFTER_DRAIN) { E.fused(acc, cur, wr, wc, fr, fq, lds, wid, lane); S.done(cur); }
#undef PG8_SA
#undef PG8_SB
#undef PG8_STAGE
#undef PG8_LDA
#undef PG8_LDB
#undef PG8_MMA
#undef PG8_WAIT_V
#undef PG8_WAIT_L
#undef PG8_BAR
#undef PG8_SCHED
}
}

#ifndef PG8_SP2
#define PG8_SP2 true
#endif
#ifndef PG8_ALIGN
#define PG8_ALIGN true
#endif
#include <hip/hip_bf16.h>
#include <cmath>
namespace attn_body {
using bf16=__hip_bfloat16;
using bf16x8=__attribute__((ext_vector_type(8)))short;
using s16x4=__attribute__((ext_vector_type(4)))short;
using f32x16=__attribute__((ext_vector_type(16)))float;
using u32x4=__attribute__((ext_vector_type(4)))unsigned;
constexpr int BATCH=4,NHEAD=16,SEQ=4096,D=64,DM=NHEAD*D;
constexpr int NW=8,QBLK=32,QB=QBLK*NW,KVBLK=64,NQB=SEQ/QB;
constexpr int ATTN_PITCH=DM, ATTN_UNIT_ROWS=QB;
__device__ __forceinline__ int crow(int r,int hi){return (r&3)+8*(r>>2)+4*hi;}
#define SBAR() __builtin_amdgcn_sched_barrier(0)
__device__ __forceinline__ void cmask(f32x16&p0,f32x16&p1,int jb,int qrel,int hi){
  const float NEG=-INFINITY; int kb=64*jb+4*hi;
  #pragma unroll
  for(int r=0;r<16;++r){int kv=kb+(r&3)+8*(r>>2); if(kv>qrel)p0[r]=NEG; if(kv+32>qrel)p1[r]=NEG;}
}

constexpr int NSLOT=3, SLOTB=8192;
constexpr int LDS_K=0, LDS_V=NSLOT*SLOTB, LDS_WS=2*NSLOT*SLOTB, LDS_OST=LDS_WS+NW*64*4, LDS_BYTES=LDS_OST+NW*4096;
constexpr float C2=0.125f*1.4426950408889634f;
__device__ __forceinline__ void glds16(const void*gsrc,unsigned lds_dst){unsigned keep;
  asm volatile("s_mov_b32 %0, m0\n\ts_mov_b32 m0, %2\n\ts_nop 0\n\tglobal_load_lds_dwordx4 %1, off\n\ts_mov_b32 m0, %0":"=&s"(keep):"v"(gsrc),"s"(lds_dst):"memory");}
__device__ __forceinline__ float max3f(float a,float b,float c){float r;asm("v_max3_f32 %0, %1, %2, %3":"=v"(r):"v"(a),"v"(b),"v"(c));return r;}
__device__ __forceinline__ float max2f(float a,float b){float r;asm("v_max_f32_e32 %0, %1, %2":"=v"(r):"v"(a),"v"(b));return r;}
__device__ __forceinline__ float fadd_s(float a,float b){float r;asm("v_add_f32_e32 %0, %1, %2":"=v"(r):"v"(a),"v"(b));return r;}
__device__ __forceinline__ float fsub_s(float a,float b){float r;asm("v_sub_f32_e32 %0, %1, %2":"=v"(r):"v"(a),"v"(b));return r;}
typedef float f32x2_t __attribute__((ext_vector_type(2))); typedef __bf16 bf16x2_t __attribute__((ext_vector_type(2)));
__device__ __forceinline__ unsigned cvtpk_s(float lo,float hi){f32x2_t v={lo,hi};bf16x2_t b=__builtin_convertvector(v,bf16x2_t);return __builtin_bit_cast(unsigned,b);}
#define WAIT_BAR(N) asm volatile("s_waitcnt vmcnt(" #N ") lgkmcnt(0)\n\ts_barrier":::"memory")

__device__ __forceinline__ void qkt(f32x16&p0,f32x16&p1,const char*Kslot,const bf16x8*qr,const f32x16&negm,int r32,int hi){
  const char*kb=Kslot+hi*1024+r32*16;
  #pragma unroll
  for(int d0=0;d0<4;++d0){
    const bf16x8 b0=*reinterpret_cast<const bf16x8*>(kb+d0*2048);
    const bf16x8 b1=*reinterpret_cast<const bf16x8*>(kb+d0*2048+512);
    if(d0==0){p0=__builtin_amdgcn_mfma_f32_32x32x16_bf16(b0,qr[0],negm,0,0,0);p1=__builtin_amdgcn_mfma_f32_32x32x16_bf16(b1,qr[0],negm,0,0,0);}
    else{p0=__builtin_amdgcn_mfma_f32_32x32x16_bf16(b0,qr[d0],p0,0,0,0);p1=__builtin_amdgcn_mfma_f32_32x32x16_bf16(b1,qr[d0],p1,0,0,0);}}
}
typedef __attribute__((address_space(3))) const char* lds_cptr;
typedef short v4i16_t __attribute__((ext_vector_type(4)));
__device__ __forceinline__ void kload8(bf16x8*kf,lds_cptr kp){
  kf[0]=*(const __attribute__((address_space(3))) bf16x8*)(kp);      kf[1]=*(const __attribute__((address_space(3))) bf16x8*)(kp+512);
  kf[2]=*(const __attribute__((address_space(3))) bf16x8*)(kp+2048); kf[3]=*(const __attribute__((address_space(3))) bf16x8*)(kp+2560);
  kf[4]=*(const __attribute__((address_space(3))) bf16x8*)(kp+4096); kf[5]=*(const __attribute__((address_space(3))) bf16x8*)(kp+4608);
  kf[6]=*(const __attribute__((address_space(3))) bf16x8*)(kp+6144); kf[7]=*(const __attribute__((address_space(3))) bf16x8*)(kp+6656);
}
__device__ __forceinline__ void kload2(bf16x8*kf,lds_cptr kp,int j){ kf[2*j]=*(const __attribute__((address_space(3))) bf16x8*)(kp+j*2048); kf[2*j+1]=*(const __attribute__((address_space(3))) bf16x8*)(kp+j*2048+512); }
__device__ __forceinline__ s16x4 vtr(lds_cptr p){ return __builtin_bit_cast(s16x4,__builtin_amdgcn_ds_read_tr16_b64_v4i16((__attribute__((address_space(3))) v4i16_t*)p)); }
__device__ __forceinline__ float rowmax(const f32x16&p0,const f32x16&p1){
  float a=max3f(p0[0],p0[1],p1[0]),b=max3f(p0[2],p0[3],p1[1]);a=max3f(a,p1[2],p1[3]);
  #pragma unroll
  for(int r=4;r<16;r+=4){a=max3f(a,p0[r],p0[r+1]);b=max3f(b,p0[r+2],p0[r+3]);a=max3f(a,p1[r],p1[r+1]);b=max3f(b,p1[r+2],p1[r+3]);}
  const float m=max2f(a,b);
  auto rr=__builtin_amdgcn_permlane32_swap(__float_as_uint(m),__float_as_uint(m),false,false);
  return max2f(__uint_as_float(rr[0]),__uint_as_float(rr[1]));
}
__device__ __forceinline__ void pv(f32x16*o,int vb,bf16x8 pa0,bf16x8 pa1,bf16x8 pa2,bf16x8 pa3){
  #pragma unroll
  for(int d0=0;d0<2;++d0){s16x4 lo[4],hi[4];
    #pragma unroll
    for(int ks=0;ks<4;++ks){
      asm volatile("ds_read_b64_tr_b16 %0,%1 offset:%c2":"=&v"(lo[ks]):"v"(vb),"i"(d0*4096+ks*1024):"memory");
      asm volatile("ds_read_b64_tr_b16 %0,%1 offset:%c2":"=&v"(hi[ks]):"v"(vb),"i"(d0*4096+ks*1024+512):"memory");}
    asm volatile("s_waitcnt lgkmcnt(0)":::"memory");SBAR();
    #define PK(k) (bf16x8){lo[k][0],lo[k][1],lo[k][2],lo[k][3],hi[k][0],hi[k][1],hi[k][2],hi[k][3]}
    o[d0]=__builtin_amdgcn_mfma_f32_32x32x16_bf16(pa0,PK(0),o[d0],0,0,0);
    o[d0]=__builtin_amdgcn_mfma_f32_32x32x16_bf16(pa1,PK(1),o[d0],0,0,0);
    o[d0]=__builtin_amdgcn_mfma_f32_32x32x16_bf16(pa2,PK(2),o[d0],0,0,0);
    o[d0]=__builtin_amdgcn_mfma_f32_32x32x16_bf16(pa3,PK(3),o[d0],0,0,0);
    #undef PK
  }
}

#ifndef ATTN_STORE16
#define ATTN_STORE16(p,v) (*(u32x4*)(p)=(v))
#endif
template<int THRL> __device__ __forceinline__ void attn_unit(int b,int h,int hv,int qb,const bf16*Q,const bf16*__restrict__ K,const bf16*__restrict__ V,bf16*O,char*shm,int mode,float lam){
  int tid_=threadIdx.x; asm volatile("":"+v"(tid_)); const int tid=tid_,lane=tid&63,r32=lane&31,hi=lane>>5; const int wid=__builtin_amdgcn_readfirstlane(tid>>6);
  const long rowbase=(long)b*SEQ; const int q0=qb*QB;
  const bf16*Qw=Q+(rowbase+q0+wid*QBLK)*DM+h*D;
  const bf16*Kh=K+rowbase*DM+h*D,*Vh=V+rowbase*DM+hv*D;
  const unsigned lds0=(unsigned)(uintptr_t)shm;
  float*wsf=(float*)(shm+LDS_WS)+wid*64;
  const bf16*ksrc=Kh+(long)lane*DM+wid*8;
  const bf16*vsrc=Vh+(long)(16*(wid&3)+(lane>>2))*DM+(wid>>2)*32+(lane&3)*8;
  const unsigned kdst=lds0+LDS_K+wid*1024, vdst=lds0+LDS_V+wid*1024;
  #define DMA_K(t,slot) glds16(ksrc+(long)(t)*KVBLK*DM,(unsigned)__builtin_amdgcn_readfirstlane(kdst+(slot)))
  #define DMA_V(t,slot) glds16(vsrc+(long)(t)*KVBLK*DM,(unsigned)__builtin_amdgcn_readfirstlane(vdst+(slot)))
  const int vb0=(int)(lds0+LDS_V)+((lane>>4)&1)*32+(lane&3)*8+(4*hi+((lane&15)>>2))*64;
  const char*Kbase=shm+LDS_K; bf16x8 kf[8];
  const lds_cptr shm3=(lds_cptr)shm; const lds_cptr kp0=shm3+LDS_K+hi*1024+r32*16; const lds_cptr vp0=shm3+LDS_V+((lane>>4)&1)*32+(lane&3)*8+(4*hi+((lane&15)>>2))*64;
  const int NT=(q0+QB)/KVBLK;
  DMA_K(0,0);DMA_V(0,0);DMA_K(1,SLOTB);
  bf16x8 qr[4];
  #pragma unroll
  for(int d0=0;d0<4;++d0)qr[d0]=*reinterpret_cast<const bf16x8*>(&Qw[(long)r32*DM+d0*16+hi*8]);
  float mhat=0.f,l_reg=0.f;f32x16 o[2];o[0]=f32x16{};o[1]=f32x16{};f32x16 negm=f32x16{};asm volatile("":"+v"(negm));
  const int qrel=wid*QBLK+r32;
  #define CMASK(P0,P1,t) do{int jb_=(t)-(NT-4); if(jb_>=0)cmask(P0,P1,jb_,qrel,hi);}while(0)
  bool resc=false;
  #define START(P0,P1) do{ const float rm=rowmax(P0,P1); resc=false; \
    { const float dl=rm; mhat=fadd_s(mhat,dl); \
      _Pragma("unroll") for(int r=0;r<16;++r){P0[r]=fsub_s(P0[r],dl);P1[r]=fsub_s(P1[r],dl);} \
      _Pragma("unroll") for(int r=0;r<16;++r)negm[r]=-mhat; asm volatile("":"+v"(negm)); } \
    _Pragma("unroll") for(int r=0;r<16;++r)P0[r]=__builtin_amdgcn_exp2f(P0[r]); }while(0)
  #define RESC() do{ if(resc){ asm volatile("s_waitcnt lgkmcnt(0)":::"memory"); \
      _Pragma("unroll") for(int d_=0;d_<2;++d_) _Pragma("unroll") for(int r=0;r<16;++r)o[d_][r]*=wsf[crow(r,hi)]; } }while(0)
  f32x16 pA0,pA1,pB0,pB1;
  int sl_prev=0,sl_cur=0,sl_next=SLOTB;
  #define ROT() do{sl_prev=sl_cur;sl_cur=sl_next;sl_next=(sl_next==(NSLOT-1)*SLOTB)?0:sl_next+SLOTB;}while(0)
  DMA_K(2,2*SLOTB);
  WAIT_BAR(3);
  qkt(pA0,pA1,Kbase,qr,negm,r32,hi);asm volatile("s_nop 15\n\ts_nop 7":"+v"(pA0),"+v"(pA1));CMASK(pA0,pA1,0);
  START(pA0,pA1);
  _Pragma("unroll") for(int r=0;r<16;++r)pA1[r]=__builtin_amdgcn_exp2f(pA1[r]);
  WAIT_BAR(0);
  DMA_K(3,0);DMA_V(1,SLOTB);
  ROT();
  kload8(kf,kp0+sl_cur);
  WAIT_BAR(2);
  s16x4 vlo[8],vhi[8]; u32x4 pw0,pw1,pw2,pw3;
  #define PKW(P,B) cvtpk_s(P[B],P[B+1])
  #define PAF(k) __builtin_bit_cast(bf16x8,pw##k)
  #define VFR(i) (bf16x8){vlo[i][0],vlo[i][1],vlo[i][2],vlo[i][3],vhi[i][0],vhi[i][1],vhi[i][2],vhi[i][3]}
  #define PIN(x) asm volatile("":"+v"(x))
  #define MX3(a,b,c) __builtin_fmaxf(__builtin_fmaxf((a),(b)),(c))
  #define GAPA(MF,A0,A1,A2,A3,W0,W1,PW) do{ MF; sacc+=A0; sacc+=A1; sacc+=A2; sacc+=A3; PIN(sacc); W0; W1; PIN(PW); SBAR(); }while(0)
  #define EX(v) __builtin_amdgcn_exp2f(v)
  #define GAPB(MF,X,B) do{ MF; X[B]=EX(X[B]); X[B+1]=EX(X[B+1]); X[B+2]=EX(X[B+2]); X[B+3]=EX(X[B+3]); PIN(X); SBAR(); }while(0)
  #define VRD(i) do{ vlo[i]=vtr(vp_+(((i)>>2)*4096+((i)&3)*1024)); vhi[i]=vtr(vp_+(((i)>>2)*4096+((i)&3)*1024+512)); }while(0)
  #define KRD(G,j) do{ if(G){ kload2(kf,kp0+sl_next,j); SBAR(); } }while(0)
  #define STEP(C0,C1,P0,P1,t,GK,GV,GL) do{ SBAR(); \
    const lds_cptr vp_=vp0+sl_prev; \
    VRD(0); SBAR(); float sacc=(P0[0]+P0[1]); \
    GAPA(C0=__builtin_amdgcn_mfma_f32_32x32x16_bf16(kf[0],qr[0],negm,0,0,0), P0[2],P0[3],P0[4],P0[5],     pw0[0]=PKW(P0,0), pw0[1]=PKW(P0,2), pw0); \
    VRD(4); SBAR(); GAPA(C1=__builtin_amdgcn_mfma_f32_32x32x16_bf16(kf[1],qr[0],negm,0,0,0), P0[6],P0[7],P0[8],P0[9],     pw0[2]=PKW(P0,4), pw0[3]=PKW(P0,6), pw0); \
    VRD(1); SBAR(); GAPA(C0=__builtin_amdgcn_mfma_f32_32x32x16_bf16(kf[2],qr[1],C0,0,0,0),   P0[10],P0[11],P0[12],P0[13], pw1[0]=PKW(P0,8), pw1[1]=PKW(P0,10), pw1); \
    VRD(5); SBAR(); GAPA(C1=__builtin_amdgcn_mfma_f32_32x32x16_bf16(kf[3],qr[1],C1,0,0,0),   P0[14],P0[15],P1[0],P1[1],   pw1[2]=PKW(P0,12),pw1[3]=PKW(P0,14), pw1); \
    VRD(2); SBAR(); GAPA(C0=__builtin_amdgcn_mfma_f32_32x32x16_bf16(kf[4],qr[2],C0,0,0,0),   P1[2],P1[3],P1[4],P1[5],     pw2[0]=PKW(P1,0), pw2[1]=PKW(P1,2), pw2); \
    VRD(6); SBAR(); GAPA(C1=__builtin_amdgcn_mfma_f32_32x32x16_bf16(kf[5],qr[2],C1,0,0,0),   P1[6],P1[7],P1[8],P1[9],     pw2[2]=PKW(P1,4), pw2[3]=PKW(P1,6), pw2); \
    VRD(3); SBAR(); GAPA(C0=__builtin_amdgcn_mfma_f32_32x32x16_bf16(kf[6],qr[3],C0,0,0,0),   P1[10],P1[11],P1[12],P1[13], pw3[0]=PKW(P1,8), pw3[1]=PKW(P1,10), pw3); \
    VRD(7); SBAR(); GAPA(C1=__builtin_amdgcn_mfma_f32_32x32x16_bf16(kf[7],qr[3],C1,0,0,0),   P1[14],P1[15],0.f,0.f,       pw3[2]=PKW(P1,12),pw3[3]=PKW(P1,14), pw3); \
    l_reg+=sacc; \
    if(GK){DMA_K((t)+3,sl_cur);} if(GV){DMA_V((t)+1,sl_next);} \
    CMASK(C0,C1,t); \
    { float a=MX3(C0[0],C0[1],C1[0]),b=MX3(C0[2],C0[3],C1[1]); a=MX3(a,C1[2],C1[3]); \
      _Pragma("unroll") for(int r=4;r<16;r+=4){a=MX3(a,C0[r],C0[r+1]);b=MX3(b,C0[r+2],C0[r+3]);a=MX3(a,C1[r],C1[r+1]);b=MX3(b,C1[r+2],C1[r+3]);} \
      float rm=__builtin_fmaxf(a,b); { auto rr=__builtin_amdgcn_permlane32_swap(__float_as_uint(rm),__float_as_uint(rm),false,false); rm=__builtin_fmaxf(__uint_as_float(rr[0]),__uint_as_float(rr[1])); } \
      resc=false; \
      if(__builtin_expect(__any(rm>(float)THRL),0)){ const float dl=__builtin_fmaxf(rm,0.f); mhat+=dl; \
        _Pragma("unroll") for(int r=0;r<16;++r){C0[r]-=dl;C1[r]-=dl;} \
        _Pragma("unroll") for(int r=0;r<16;++r)negm[r]=-mhat; asm volatile("":"+v"(negm)); \
        const float f=__builtin_amdgcn_exp2f(-dl); l_reg*=f; if(hi==0)wsf[r32]=f; resc=true; } } \
    SBAR(); \
    GAPB(o[0]=__builtin_amdgcn_mfma_f32_32x32x16_bf16(PAF(0),VFR(0),o[0],0,0,0), C0,0); \
    GAPB(o[1]=__builtin_amdgcn_mfma_f32_32x32x16_bf16(PAF(0),VFR(4),o[1],0,0,0), C0,4); \
    KRD(GL,0); GAPB(o[0]=__builtin_amdgcn_mfma_f32_32x32x16_bf16(PAF(1),VFR(1),o[0],0,0,0), C0,8); \
    KRD(GL,1); GAPB(o[1]=__builtin_amdgcn_mfma_f32_32x32x16_bf16(PAF(1),VFR(5),o[1],0,0,0), C0,12); \
    KRD(GL,2); GAPB(o[0]=__builtin_amdgcn_mfma_f32_32x32x16_bf16(PAF(2),VFR(2),o[0],0,0,0), C1,0); \
    KRD(GL,3); GAPB(o[1]=__builtin_amdgcn_mfma_f32_32x32x16_bf16(PAF(2),VFR(6),o[1],0,0,0), C1,4); \
    GAPB(o[0]=__builtin_amdgcn_mfma_f32_32x32x16_bf16(PAF(3),VFR(3),o[0],0,0,0), C1,8); \
    GAPB(o[1]=__builtin_amdgcn_mfma_f32_32x32x16_bf16(PAF(3),VFR(7),o[1],0,0,0), C1,12); \
    }while(0)
  int t=1;
  #undef CMASK
  #define CMASK(P0,P1,t) do{}while(0)
  for(;t+5<NT;t+=2){
    STEP(pB0,pB1,pA0,pA1,t,true,true,true);     WAIT_BAR(2); RESC(); ROT();
    STEP(pA0,pA1,pB0,pB1,t+1,true,true,true);   WAIT_BAR(2); RESC(); ROT();
  }
  #undef CMASK
  #define CMASK(P0,P1,t) do{int jb_=(t)-(NT-4); if(jb_>=0)cmask(P0,P1,jb_,qrel,hi);}while(0)
  #define ENDW(tt) do{ if((tt)+3<NT){WAIT_BAR(2);} else if((tt)+2<NT){WAIT_BAR(1);} else {WAIT_BAR(0);} }while(0)
  for(;t+1<NT;t+=2){
    STEP(pB0,pB1,pA0,pA1,t,(t+3<NT),(t+1<NT),(t+1<NT));       ENDW(t);   RESC(); ROT();
    STEP(pA0,pA1,pB0,pB1,t+1,(t+4<NT),(t+2<NT),(t+2<NT));     ENDW(t+1); RESC(); ROT();
  }
  STEP(pB0,pB1,pA0,pA1,NT-1,false,false,false); RESC();
  { float sacc=pB0[0]+pB0[1]; _Pragma("unroll") for(int r=2;r<16;++r)sacc+=pB0[r]; _Pragma("unroll") for(int r=0;r<16;++r)sacc+=pB1[r]; l_reg+=sacc;
    pw0=(u32x4){PKW(pB0,0),PKW(pB0,2),PKW(pB0,4),PKW(pB0,6)};pw1=(u32x4){PKW(pB0,8),PKW(pB0,10),PKW(pB0,12),PKW(pB0,14)};pw2=(u32x4){PKW(pB1,0),PKW(pB1,2),PKW(pB1,4),PKW(pB1,6)};pw3=(u32x4){PKW(pB1,8),PKW(pB1,10),PKW(pB1,12),PKW(pB1,14)};
    SBAR(); pv(o,vb0+sl_cur,PAF(0),PAF(1),PAF(2),PAF(3)); }
  #undef PKW
  #undef PAF
  #undef VFR
  #undef PIN
  #undef MX3
  #undef GAPA
  #undef GAPB
  #undef EX
  #undef VRD
  #undef KRD
  #undef STEP
  #undef ENDW
  {auto rr=__builtin_amdgcn_permlane32_swap(__float_as_uint(l_reg),__float_as_uint(l_reg),false,false);l_reg=__uint_as_float(rr[0])+__uint_as_float(rr[1]);}
  if(hi==0)wsf[32+r32]=l_reg;asm volatile("s_waitcnt lgkmcnt(0)":::"memory");
  float rli[16];
  #pragma unroll
  for(int r=0;r<16;++r)rli[r]=__builtin_amdgcn_rcpf(wsf[32+crow(r,hi)]);
  bf16*Ow=O+(rowbase+q0+wid*QBLK)*DM+hv*D;
  { bf16*stg=(bf16*)(shm+LDS_OST)+wid*2048;
    #pragma unroll
    for(int r=0;r<16;++r){const int orow=crow(r,hi);
      #pragma unroll
      for(int d0=0;d0<2;++d0)stg[orow*64+d0*32+r32]=__float2bfloat16(o[d0][r]*rli[r]);}
    asm volatile("s_waitcnt lgkmcnt(0)":::"memory");
    #pragma unroll
    for(int i=0;i<4;++i){const int row=i*8+(lane>>3),ch=lane&7; u32x4 v=*(const u32x4*)(stg+row*64+ch*8);
      if(mode){ const u32x4 ov=*(const u32x4*)(Ow+(long)row*DM+ch*8);
        #pragma unroll
        for(int e=0;e<4;++e){ const float a0=__uint_as_float(ov[e]<<16), a1=__uint_as_float(ov[e]&0xffff0000u), c0=__uint_as_float(v[e]<<16), c1=__uint_as_float(v[e]&0xffff0000u);
          v[e]=cvtpk_s(a0-lam*c0,a1-lam*c1); } }
      ATTN_STORE16(Ow+(long)row*DM+ch*8,v);} }
  asm volatile("s_waitcnt lgkmcnt(0)\n\ts_barrier":::"memory");
  #undef DMA_K
  #undef DMA_V
  #undef CMASK
  #undef START
  #undef RESC
  #undef ROT
}
constexpr int ATTN_LDS_BYTES=LDS_BYTES;
#undef SBAR
#undef WAIT_BAR
}
#include <hip/hip_cooperative_groups.h>
namespace cg = cooperative_groups;
constexpr int NWAVES = 8, NTHR = 512;
constexpr int DEPTH = 2, M = 32768, MH = 16384, DM = 1024, FF = 2816, SEQ = 4096, CIN = 8208;
constexpr float EPS = 1e-6f;
constexpr size_t MiB = 1u << 20;
constexpr size_t WS_WG = 1 * MiB;
constexpr size_t WS_W = 2 * MiB, W_LSTRIDE = 55 * MiB;
constexpr size_t WO_GU1 = 0, WO_DN1 = 11 * MiB, WO_WIN = 11 * MiB + MiB / 2 + 5 * MiB, WO_WA = WO_WIN + 16 * MiB, WO_WM = WO_WA + 2 * MiB, WO_WO = WO_WM + 2 * MiB,
                 WO_GU2 = WO_WO + 2 * MiB, WO_DN2 = WO_GU2 + 11 * MiB;
static_assert(WO_DN2 + 5 * MiB + MiB / 2 == W_LSTRIDE, "weight map");
constexpr size_t WS_XN = 112 * MiB, WS_GATES = 176 * MiB, WS_CST = 178 * MiB, WS_NL = 210 * MiB, WS_BL = WS_NL + 512 * 1024, WS_ML = WS_BL + 64 * 1024, WS_MP = WS_ML + 64 * 1024;
constexpr size_t WS_YA = 212 * MiB, WS_Z = 244 * MiB, ZSTRIDE = 32 * MiB;
constexpr size_t WS_ACT = 212 * MiB, WS_Y = 388 * MiB, WS_END = 500 * MiB;
static_assert(WS_ACT + (size_t)M * FF * 2 <= WS_Y && WS_Y + (size_t)M * DM * 2 <= WS_END && WS_Z + 8 * ZSTRIDE == WS_END, "ws map");
constexpr int RING_BYTES = 131072, LDS_BYTES = 147456;

#define LAS __attribute__((address_space(3)))
typedef unsigned short bf16;
typedef unsigned v4u __attribute__((ext_vector_type(4)));
typedef unsigned v2u __attribute__((ext_vector_type(2)));
typedef float f32x4 __attribute__((ext_vector_type(4)));
typedef short bf16x8 __attribute__((ext_vector_type(8)));
__device__ __forceinline__ float bf2f(bf16 b) { return __uint_as_float((unsigned)b << 16); }
__device__ __forceinline__ float bflo(unsigned w) { return __uint_as_float(w << 16); }
__device__ __forceinline__ float bfhi(unsigned w) { return __uint_as_float(w & 0xffff0000u); }
__device__ __forceinline__ unsigned pkbf(float lo, float hi) { return pg8::cvt_pk_bf16(lo, hi); }
__device__ __forceinline__ unsigned pkbf_c(float lo, float hi) { return attn_body::cvtpk_s(lo, hi); }
__device__ __forceinline__ float sigmf(float x) { return 1.0f / (1.0f + __expf(-x)); }
__device__ __forceinline__ float lx_xor(float v, int o, int lane) { return __int_as_float(__builtin_amdgcn_ds_bpermute((lane ^ o) << 2, __float_as_int(v))); }
__device__ __forceinline__ float lx_up(float v, int o, int lane) { const int src = lane >= o ? lane - o : lane; return __int_as_float(__builtin_amdgcn_ds_bpermute(src << 2, __float_as_int(v))); }
__device__ __forceinline__ float lx_last(float v) { return __int_as_float(__builtin_amdgcn_readlane(__float_as_int(v), 63)); }
__device__ __forceinline__ float wave_sum(float v, int lane) {
#pragma unroll
    for (int o = 1; o < 64; o <<= 1) v += lx_xor(v, o, lane);
    return v;
}
__device__ __forceinline__ float wave_max(float v, int lane) {
#pragma unroll
    for (int o = 1; o < 64; o <<= 1) v = fmaxf(v, lx_xor(v, o, lane));
    return v;
}

#define XB_TMO      128
#define XB_XCNT(j)  (256  + 64 * (j))
#define XB_XSUB(j)  (1280 + 64 * (j))
#define XB_XGEN(j)  (2304 + 64 * (j))
#define XB_TOP      3328
#define XB_TOPGEN   3392
#define XCD_BAR_WORDS 3456
#define XB_SPIN_CAP (1u << 18)

__device__ __forceinline__ unsigned xb_ld(unsigned* p)              { return __hip_atomic_load(p, __ATOMIC_RELAXED, __HIP_MEMORY_SCOPE_AGENT); }
__device__ __forceinline__ unsigned xb_add(unsigned* p, unsigned v) { return __hip_atomic_fetch_add(p, v, __ATOMIC_RELAXED, __HIP_MEMORY_SCOPE_AGENT); }
__device__ __forceinline__ unsigned xb_xcc_id() { return (unsigned)__builtin_amdgcn_s_getreg((3 << 11) | 20) & 0xFu; }
#define XB_SPIN(cond, bar) do { unsigned _sp = 0; while (cond) { __builtin_amdgcn_s_sleep(1); \
    if ((++_sp & 255u) == 0u) { if (xb_ld(&(bar)[XB_TMO])) break; if (_sp > XB_SPIN_CAP) { atomicAdd(&(bar)[XB_TMO], 1u); break; } } } } while (0)

struct XcdBarrier {
    unsigned* bar; unsigned x;
    volatile LAS unsigned* st;
};

__device__ __forceinline__ XcdBarrier xcd_barrier_post(unsigned* bar, volatile LAS unsigned* st) {
    XcdBarrier b; b.bar = bar; b.x = xb_xcc_id(); b.st = st;
    if (threadIdx.x == 0) (void)xb_add(&bar[XB_XCNT(b.x)], 1u);
    return b;
}
__device__ __forceinline__ void xcd_barrier_complete(unsigned* bar, unsigned x, unsigned& nloc, unsigned& nx) {
    const unsigned G = gridDim.x * gridDim.y * gridDim.z;
    unsigned sum, cnt, mine, sp = 0u;
    for (;;) {
        sum = 0u; cnt = 0u; mine = 0u;
#pragma unroll
        for (unsigned j = 0; j < 16; ++j) { const unsigned c = xb_ld(&bar[XB_XCNT(j)]); sum += c; cnt += (c > 0u) ? 1u : 0u; mine = (j == x) ? c : mine; }
        if (sum == G) break;
        __builtin_amdgcn_s_sleep(1);
        if ((++sp & 255u) == 0u) { if (xb_ld(&bar[XB_TMO])) break; if (sp > XB_SPIN_CAP) { atomicAdd(&bar[XB_TMO], 1u); break; } }
    }
    nloc = mine > 0u ? mine : 1u; nx = cnt > 0u ? cnt : 1u;
}

__device__ __forceinline__ void xcd_barrier(const XcdBarrier& b) {
    asm volatile("s_waitcnt vmcnt(0)" ::: "memory");
    __syncthreads();
    if (threadIdx.x == 0) {
        unsigned* bar = b.bar;
        __builtin_amdgcn_s_waitcnt(0);
        unsigned nloc = b.st[0], nx = b.st[1];
        if (nloc == 0u) { xcd_barrier_complete(bar, b.x, nloc, nx); b.st[0] = nloc; b.st[1] = nx; }
        const unsigned old = xb_add(&bar[XB_XSUB(b.x)], 1u);
        const unsigned gen = old / nloc;
        if (old + 1u == (gen + 1u) * nloc) {
            __builtin_amdgcn_fence(__ATOMIC_RELEASE, "agent");
            asm volatile("s_waitcnt vmcnt(0)" ::: "memory");
            const unsigned og = xb_add(&bar[XB_TOP], 1u);
            const unsigned tg = og / nx;
            if (og + 1u == (tg + 1u) * nx) xb_add(&bar[XB_TOPGEN], 1u);
            else XB_SPIN(xb_ld(&bar[XB_TOPGEN]) == tg, bar);
            __builtin_amdgcn_fence(__ATOMIC_ACQUIRE, "agent");
            xb_add(&bar[XB_XGEN(b.x)], 1u);
            asm volatile("s_waitcnt vmcnt(0)" ::: "memory");
        } else {
            XB_SPIN(xb_ld(&bar[XB_XGEN(b.x)]) == gen, bar);
            __builtin_amdgcn_fence(__ATOMIC_ACQUIRE, "agent");
            asm volatile("s_waitcnt vmcnt(0)" ::: "memory");
        }
    }
    __syncthreads();
}

#ifdef DBG_CODES
#define DBGCHK(ws_, code, val) do { const float v__ = (val); if (!(fabsf(v__) < 1e30f)) atomicMax((unsigned*)((ws_) + 40960), 100u - (unsigned)(code)); } while (0)
#else
#define DBGCHK(ws_, code, val) do {} while (0)
#endif
struct Args { const float* in[26]; float* out; unsigned char* ws; int ph_lo, ph_hi; };

__device__ __forceinline__ void tr_block(const float* W, int ldw, int K, int c0, bf16* WT, int r0, int kb, const float* ks, int kmask, float mul, LAS float* scr, int lane) {
    const int k0 = 64 * kb;
#pragma unroll 8
    for (int i = 0; i < 32; ++i) { const int kk = 2 * i + (lane >> 5); float v = W[(size_t)(k0 + kk) * ldw + c0 + (lane & 31)]; if (ks) v *= ks[(k0 + kk) & kmask]; scr[kk * 33 + (lane & 31)] = v * mul; }
    asm volatile("s_waitcnt lgkmcnt(0)" ::: "memory");
    const int c = lane & 7;
#pragma unroll
    for (int j = 0; j < 4; ++j) { const int n = (lane >> 3) + 8 * j; const LAS float* s = scr + (8 * c) * 33 + n;
        v4u o; o.x = pkbf(s[0 * 33], s[1 * 33]); o.y = pkbf(s[2 * 33], s[3 * 33]); o.z = pkbf(s[4 * 33], s[5 * 33]); o.w = pkbf(s[6 * 33], s[7 * 33]);
        *(v4u*)(WT + (size_t)(r0 + n) * K + k0 + 8 * c) = o; }
    asm volatile("s_waitcnt lgkmcnt(0)" ::: "memory");
}
constexpr int IT_GU = 176 * 16, IT_DN = 32 * 44, IT_WIN = 256 * 16, IT_SQ = 32 * 16, IT_LAYER = 2 * IT_GU + 2 * IT_DN + IT_WIN + 3 * IT_SQ;
__device__ __forceinline__ void convert_item(const Args& a, int it, LAS float* scr, int lane) {
    const int l = it / IT_LAYER; int r = it % IT_LAYER;
    unsigned char* wb = a.ws + WS_W + (size_t)l * W_LSTRIDE;
    const float lam_init = 0.8f - 0.6f * expf(-0.3f * (float)l);
    for (int f = 0; f < 2; ++f) {
        const float* gu = a.in[f ? 23 : 2] + (size_t)l * DM * 2 * FF; const float* dn = a.in[f ? 24 : 3] + (size_t)l * FF * DM;
        if (r < IT_GU) { const int nb = r % 176, kb = r / 176, c0 = nb * 32, isu = c0 >= FF, fe = c0 - (isu ? FF : 0);
            tr_block(gu, 2 * FF, DM, c0, (bf16*)(wb + (f ? WO_GU2 : WO_GU1)), 256 * (fe >> 7) + 128 * isu + (fe & 127), kb, nullptr, 0, 1.f, scr, lane); return; } r -= IT_GU;
        if (r < IT_DN) { const int nb = r % 32, kb = r / 32; tr_block(dn, DM, FF, nb * 32, (bf16*)(wb + (f ? WO_DN2 : WO_DN1)), nb * 32, kb, nullptr, 0, 1.f, scr, lane); return; } r -= IT_DN;
    }
    if (r < IT_WIN) { const int nb = r % 256, kb = r / 256; const int c0 = nb < 192 ? nb * 32 : 6160 + (nb - 192) * 32;
        tr_block(a.in[6] + (size_t)l * DM * CIN, CIN, DM, c0, (bf16*)(wb + WO_WIN), nb * 32, kb, nullptr, 0, 1.f, scr, lane); return; } r -= IT_WIN;
    const int which = r / IT_SQ; r %= IT_SQ; const int nb = r % 32, kb = r / 32;
    if (which == 0) tr_block(a.in[17] + (size_t)l * DM * DM, DM, DM, nb * 32, (bf16*)(wb + WO_WA), nb * 32, kb, a.in[11] + l * 128, 127, 1.f - lam_init, scr, lane);
    else if (which == 1) tr_block(a.in[18] + (size_t)l * DM * DM, DM, DM, nb * 32, (bf16*)(wb + WO_WM), nb * 32, kb, a.in[16] + l * 1024, 1023, 1.f, scr, lane);
    else tr_block(a.in[20] + (size_t)l * DM * DM, DM, DM, nb * 32, (bf16*)(wb + WO_WO), nb * 32, kb, nullptr, 0, 1.f, scr, lane);
}

__device__ __forceinline__ void row_update(const float* xin, float* xout, const bf16* Y, float ysc, const float* wpost, const float* wnext, bf16* XN, size_t row, int lane) {
    const f32x4* xr = (const f32x4*)(xin + row * DM) + lane;
    f32x4 xv[4];
#pragma unroll
    for (int j = 0; j < 4; ++j) xv[j] = xr[64 * j];
    if (Y) {
        const v2u* yr = (const v2u*)(Y + row * DM) + lane; f32x4 yv[4]; float ss = 0.f;
#pragma unroll
        for (int j = 0; j < 4; ++j) { const v2u w = yr[64 * j]; yv[j] = (f32x4){bflo(w.x), bfhi(w.x), bflo(w.y), bfhi(w.y)}; ss += (yv[j].x * yv[j].x + yv[j].y * yv[j].y) + (yv[j].z * yv[j].z + yv[j].w * yv[j].w); }
        const float rs = ysc * rsqrtf(wave_sum(ss, lane) * (1.f / DM) + EPS);
        f32x4* xo = (f32x4*)(xout + row * DM) + lane;
#pragma unroll
        for (int j = 0; j < 4; ++j) { const f32x4 wp = ((const f32x4*)wpost)[lane + 64 * j]; xv[j] = xv[j] + yv[j] * wp * rs;
#ifdef DBG_NANPROBE
            for (int e = 0; e < 4; ++e) if (!(fabsf(xv[j][e]) < 1e30f)) xv[j][e] = 100.f;
#endif
            xo[64 * j] = xv[j]; }
    }
    if (wnext) {
        float ss = 0.f;
#pragma unroll
        for (int j = 0; j < 4; ++j) ss += (xv[j].x * xv[j].x + xv[j].y * xv[j].y) + (xv[j].z * xv[j].z + xv[j].w * xv[j].w);
        const float rs = rsqrtf(wave_sum(ss, lane) * (1.f / DM) + EPS);
        v2u* xo = (v2u*)(XN + row * DM) + lane;
#pragma unroll
        for (int j = 0; j < 4; ++j) { const f32x4 wn = ((const f32x4*)wnext)[lane + 64 * j]; const f32x4 h = xv[j] * wn * rs; v2u w; w.x = pkbf(h.x, h.y); w.y = pkbf(h.z, h.w); xo[64 * j] = w; }
    }
}
__device__ __forceinline__ void row_phase(const float* xin, float* xout, const bf16* Y, float ysc, const float* wpost, const float* wnext, bf16* XN,
                                          int row_lo, int nrows, const bf16* WGt, const float* igb, const float* fgb, float* GATES, int gw, int ngw, int lane) {
    for (int grp = gw; grp < nrows / 16; grp += ngw) {
        const size_t r0 = (size_t)row_lo + (size_t)grp * 16;
        for (int i = 0; i < 16; ++i) row_update(xin, xout, Y, ysc, wpost, wnext, XN, r0 + i, lane);
        if (WGt) {
            asm volatile("s_waitcnt vmcnt(0)" ::: "memory");
            __builtin_amdgcn_fence(__ATOMIC_ACQUIRE, "agent");
            const int fr = lane & 15, fq = lane >> 4;
            f32x4 acc = (f32x4){0.f, 0.f, 0.f, 0.f};
            const bf16* ap = XN + (r0 + fr) * DM + 8 * fq; const bf16* bp = WGt + fr * DM + 8 * fq;
#pragma unroll 8
            for (int ks = 0; ks < 32; ++ks) { const bf16x8 av = *(const bf16x8*)(ap + 32 * ks), bv = *(const bf16x8*)(bp + 32 * ks); acc = __builtin_amdgcn_mfma_f32_16x16x32_bf16(av, bv, acc, 0, 0, 0); }
            const float bias = fr < 8 ? igb[fr] : fgb[fr - 8];
#pragma unroll
            for (int i = 0; i < 4; ++i) GATES[(r0 + 4 * fq + i) * 16 + fr] = acc[i] + bias;
        }
    }
}

__device__ __forceinline__ void gates_phase(const bf16* XN, const bf16* WGt, const float* igb, const float* fgb, float* GATES, int row_lo, int nrows, int gw, int ngw, int lane) {
    const int fr = lane & 15, fq = lane >> 4;
    for (int grp = gw; grp < nrows / 16; grp += ngw) {
        const size_t r0 = (size_t)row_lo + (size_t)grp * 16;
        f32x4 acc = (f32x4){0.f, 0.f, 0.f, 0.f};
        const bf16* ap = XN + (r0 + fr) * DM + 8 * fq; const bf16* bp = WGt + fr * DM + 8 * fq;
#pragma unroll 8
        for (int ks = 0; ks < 32; ++ks) { const bf16x8 av = *(const bf16x8*)(ap + 32 * ks), bv = *(const bf16x8*)(bp + 32 * ks); acc = __builtin_amdgcn_mfma_f32_16x16x32_bf16(av, bv, acc, 0, 0, 0); }
        const float bias = fr < 8 ? igb[fr] : fgb[fr - 8];
#pragma unroll
        for (int i = 0; i < 4; ++i) GATES[(r0 + 4 * fq + i) * 16 + fr] = acc[i] + bias;
    }
}
__device__ __forceinline__ void gate_scan(const float* grow, int h, int lane, float& ig, float& bcum) {
    const float* g = grow + lane * 16; ig = g[h]; const float f = g[8 + h];
    float lf = fminf(f, 0.f) - log1pf(__expf(-fabsf(f)));
#pragma unroll
    for (int o = 1; o < 64; o <<= 1) { const float t = lx_up(lf, o, lane); if (lane >= o) lf += t; }
    bcum = lf;
}
__device__ __forceinline__ void conv8(const bf16* MQK, size_t r0, int c, int ch, int rg, const float* cw, const float* cb, float (&out)[8]) {
    const float w0 = cw[ch], w1 = cw[1024 + ch], w2 = cw[2048 + ch], w3 = cw[3072 + ch], b = cb[ch];
    float x[11];
#pragma unroll
    for (int j = 0; j < 11; ++j) { const bool ok = !(c == 0 && rg == 0 && j < 3); x[j] = 0.f; if (ok) x[j] = bf2f(MQK[(r0 + rg * 8 + j - 3) * DM + ch]); }
#pragma unroll
    for (int i = 0; i < 8; ++i) { const float v = b + w0 * x[i] + w1 * x[i + 1] + w2 * x[i + 2] + w3 * x[i + 3]; out[i] = v * sigmf(v); }
}
constexpr int KP = 72, AP = 136;
__device__ __forceinline__ void m1_unit(LAS unsigned char* L, int u, const bf16* MQK, const bf16* MV, const float* GATESh, const float* cw, const float* cb,
                                        bf16* CST, float* NL, float* BLs, float* MLs, int tid, unsigned char* dws) {
    const int lane = tid & 63, wave = tid >> 6, fr = lane & 15, fq = lane >> 4;
    const int c = u & 63, bh = u >> 6, h = bh & 7, bl = bh >> 3; const size_t r0 = (size_t)bl * SEQ + c * 64;
    LAS float* WV = (LAS float*)L; LAS unsigned char* KT = L + 256; LAS unsigned char* VT = L + 256 + 64 * KP * 2;
    if (wave == 0) { float ig, bc; gate_scan(GATESh + r0 * 16, h, lane, ig, bc); DBGCHK(dws, 1, ig); DBGCHK(dws, 2, bc);
        const float blast = lx_last(bc), a = blast - bc + ig, ml = wave_max(a, lane); WV[lane] = __expf(a - ml); DBGCHK(dws, 3, WV[lane]);
        if (lane == 0) { BLs[u] = blast; MLs[u] = ml; } }
    __syncthreads();
    { const int d = tid & 63, rg = tid >> 6; float o[8]; conv8(MQK, r0, c, 512 + h * 64 + d, rg, cw, cb, o);
#pragma unroll
      for (int i = 0; i < 8; ++i) o[i] *= WV[rg * 8 + i];
      v4u w; w.x = pkbf(o[0], o[1]); w.y = pkbf(o[2], o[3]); w.z = pkbf(o[4], o[5]); w.w = pkbf(o[6], o[7]);
      *(LAS v4u*)(KT + d * (KP * 2) + rg * 16) = w; }
#pragma unroll
    for (int k = 0; k < 2; ++k) { const int t = tid + 512 * k, v = t & 127, rg = t >> 7; unsigned short e[8];
#pragma unroll
        for (int i = 0; i < 8; ++i) e[i] = MV[(r0 + rg * 8 + i) * DM + h * 128 + v];
        v4u w; w.x = e[0] | ((unsigned)e[1] << 16); w.y = e[2] | ((unsigned)e[3] << 16); w.z = e[4] | ((unsigned)e[5] << 16); w.w = e[6] | ((unsigned)e[7] << 16);
        *(LAS v4u*)(VT + v * (KP * 2) + rg * 16) = w; }
    __syncthreads();
    { bf16* ct = CST + (size_t)u * 8192;
#pragma unroll
      for (int j = 0; j < 4; ++j) { f32x4 acc = (f32x4){0.f, 0.f, 0.f, 0.f};
#pragma unroll
          for (int ks = 0; ks < 2; ++ks) { const bf16x8 af = *(const LAS bf16x8*)(KT + (16 * j + fr) * (KP * 2) + (32 * ks + 8 * fq) * 2), bf = *(const LAS bf16x8*)(VT + (16 * wave + fr) * (KP * 2) + (32 * ks + 8 * fq) * 2);
              acc = __builtin_amdgcn_mfma_f32_16x16x32_bf16(af, bf, acc, 0, 0, 0); }
          DBGCHK(dws, 4, acc[0] + acc[1] + acc[2] + acc[3]);
          v2u w; w.x = pkbf_c(acc[0], acc[1]); w.y = pkbf_c(acc[2], acc[3]);
          *(v2u*)(ct + (16 * wave + fr) * 64 + 16 * j + 4 * fq) = w; } }
    if (tid < 64) { float s = 0.f; const LAS bf16* kr = (const LAS bf16*)(KT + tid * (KP * 2));
#pragma unroll 8
        for (int l = 0; l < 64; ++l) s += bf2f(kr[l]);
        NL[(size_t)u * 64 + tid] = s; }
    __syncthreads();
}
__device__ __forceinline__ void m2_item(int item, unsigned* C32, float* NL, const float* BLs, const float* MLs, float* MP, int tid, unsigned char* dws) {
    const int bh = item >> 3, part = item & 7, e = part * 512 + tid; const int ub = bh * 64;
    float s0 = 0.f, s1 = 0.f, ns = 0.f, m = 0.f; const bool don = (part == 0 && tid < 64);
    for (int c0 = 0; c0 < 64; c0 += 8) {
        unsigned ld[8]; float nl[8];
#pragma unroll
        for (int i = 0; i < 8; ++i) { ld[i] = C32[(size_t)(ub + c0 + i) * 4096 + e]; nl[i] = don ? NL[(size_t)(ub + c0 + i) * 64 + tid] : 0.f; }
#pragma unroll
        for (int i = 0; i < 8; ++i) { const int u = ub + c0 + i; const float bl = BLs[u], ml = MLs[u];
            const float mn = fmaxf(bl + m, ml), sp = __expf(bl + m - mn), sl = __expf(ml - mn);
            DBGCHK(dws, 5, s0 + s1 + sp + sl);
            C32[(size_t)u * 4096 + e] = pkbf(s0, s1); s0 = sp * s0 + sl * bflo(ld[i]); s1 = sp * s1 + sl * bfhi(ld[i]);
            if (don) { NL[(size_t)u * 64 + tid] = ns; ns = sp * ns + sl * nl[i]; }
            if (part == 0 && tid == 0) MP[u] = m;
            m = mn; }
    }
}
__device__ __forceinline__ void m3_unit(LAS unsigned char* L, int u, const bf16* MQK, bf16* MV, const bf16* MO, const float* GATESh, const float* cw, const float* cb,
                                        const bf16* CST, const float* NL, const float* MP, int tid, unsigned char* dws) {
    const int lane = tid & 63, wave = tid >> 6, fr = lane & 15, fq = lane >> 4;
    const int c = u & 63, bh = u >> 6, h = bh & 7, bl = bh >> 3; const size_t r0 = (size_t)bl * SEQ + c * 64;
    LAS float* RT = (LAS float*)L; LAS float* SCI = RT + 64; LAS float* GS = RT + 128; LAS float* EMT = RT + 192; LAS float* NN = RT + 256; LAS float* DEN = RT + 384; LAS float* SSQ = RT + 448;
    LAS unsigned char* QC = L + 2304; LAS unsigned char* KC = QC + 64 * KP * 2; LAS unsigned char* AA = KC + 64 * KP * 2; LAS unsigned char* BB = AA + 64 * AP * 2;
    if (wave == 0) { float ig, bc; gate_scan(GATESh + r0 * 16, h, lane, ig, bc); const float g = ig - bc; float pm = g;
#pragma unroll
        for (int o = 1; o < 64; o <<= 1) { const float t = lx_up(pm, o, lane); if (lane >= o) pm = fmaxf(pm, t); }
        const float mp = MP[u], mt = bc + fmaxf(mp, pm);
        RT[lane] = bc - mt; SCI[lane] = __expf(bc + mp - mt); GS[lane] = g; EMT[lane] = __expf(-mt); DBGCHK(dws, 6, mp); DBGCHK(dws, 7, EMT[lane] + SCI[lane] + RT[lane] + g); }
    if (wave == 1) { NN[lane] = NL[(size_t)u * 64 + lane]; NN[64 + lane] = 1.f; }
    { const int d = tid & 63, rg = tid >> 6; float o[8];
      conv8(MQK, r0, c, h * 64 + d, rg, cw, cb, o);
#pragma unroll
      for (int i = 0; i < 8; ++i) *(LAS bf16*)(QC + ((rg * 8 + i) * KP + d) * 2) = (bf16)(pkbf(o[i] * 0.125f, 0.f) & 0xffffu);
      conv8(MQK, r0, c, 512 + h * 64 + d, rg, cw, cb, o);
#pragma unroll
      for (int i = 0; i < 8; ++i) *(LAS bf16*)(KC + ((rg * 8 + i) * KP + d) * 2) = (bf16)(pkbf(o[i], 0.f) & 0xffffu); }
#pragma unroll
    for (int k = 0; k < 2; ++k) { const int t = tid + 512 * k, v = t & 127, rg = t >> 7; unsigned short e[8];
#pragma unroll
        for (int i = 0; i < 8; ++i) e[i] = MV[(r0 + rg * 8 + i) * DM + h * 128 + v];
        v4u w; w.x = e[0] | ((unsigned)e[1] << 16); w.y = e[2] | ((unsigned)e[3] << 16); w.z = e[4] | ((unsigned)e[5] << 16); w.w = e[6] | ((unsigned)e[7] << 16);
        *(LAS v4u*)(BB + v * (AP * 2) + (64 + rg * 8) * 2) = w; }
#pragma unroll
    for (int k = 0; k < 2; ++k) { const int t = tid + 512 * k, v = t >> 3, p = t & 7; *(LAS v4u*)(BB + v * (AP * 2) + p * 16) = *(const v4u*)(CST + (size_t)u * 8192 + v * 64 + p * 8); }
    __syncthreads();
    { const int lt = wave & 3;
      const int l = 16 * lt + fr; const float rt = RT[l];
#pragma unroll
      for (int q = 0; q < 2; ++q) { const int st = (wave >> 2) * 2 + q; f32x4 acc = (f32x4){0.f, 0.f, 0.f, 0.f};
#pragma unroll
          for (int ks = 0; ks < 2; ++ks) { const bf16x8 af = *(const LAS bf16x8*)(KC + (16 * st + fr) * (KP * 2) + (32 * ks + 8 * fq) * 2), bf = *(const LAS bf16x8*)(QC + (16 * lt + fr) * (KP * 2) + (32 * ks + 8 * fq) * 2);
              acc = __builtin_amdgcn_mfma_f32_16x16x32_bf16(af, bf, acc, 0, 0, 0); }
          float p[4];
#pragma unroll
          for (int i = 0; i < 4; ++i) { const int s = 16 * st + 4 * fq + i; p[i] = (s <= l) ? __expf(rt + GS[s]) * acc[i] : 0.f; }
          DBGCHK(dws, 8, p[0] + p[1] + p[2] + p[3]);
          v2u w; w.x = pkbf(p[0], p[1]); w.y = pkbf(p[2], p[3]); *(LAS v2u*)(AA + l * (AP * 2) + (64 + 16 * st + 4 * fq) * 2) = w; }
      const int l2 = tid >> 3, p8 = tid & 7; const float sc = SCI[l2]; const v4u qv = *(const LAS v4u*)(QC + l2 * (KP * 2) + p8 * 16); v4u o;
      o.x = pkbf(sc * bflo(qv.x), sc * bfhi(qv.x)); o.y = pkbf(sc * bflo(qv.y), sc * bfhi(qv.y)); o.z = pkbf(sc * bflo(qv.z), sc * bfhi(qv.z)); o.w = pkbf(sc * bflo(qv.w), sc * bfhi(qv.w));
      *(LAS v4u*)(AA + l2 * (AP * 2) + p8 * 16) = o; }
    __syncthreads();
    f32x4 acc[4];
    { const int lt = wave & 3;
#pragma unroll
      for (int i = 0; i < 8; ++i) { const int l = wave * 8 + i; const LAS bf16* ar = (const LAS bf16*)(AA + l * (AP * 2));
          const float s = wave_sum(bf2f(ar[lane]) * NN[lane] + bf2f(ar[64 + lane]) * NN[64 + lane], lane); if (lane == 0) DEN[l] = s; }
#pragma unroll
      for (int j = 0; j < 4; ++j) { const int vt = (wave >> 2) * 4 + j; acc[j] = (f32x4){0.f, 0.f, 0.f, 0.f};
#pragma unroll
          for (int ks = 0; ks < 4; ++ks) { const bf16x8 af = *(const LAS bf16x8*)(BB + (16 * vt + fr) * (AP * 2) + (32 * ks + 8 * fq) * 2), bf = *(const LAS bf16x8*)(AA + (16 * lt + fr) * (AP * 2) + (32 * ks + 8 * fq) * 2);
              acc[j] = __builtin_amdgcn_mfma_f32_16x16x32_bf16(af, bf, acc[j], 0, 0, 0); } } }
    __syncthreads();
    { const int lt = wave & 3, l = 16 * lt + fr; const float inv = 1.0f / fmaxf(fabsf(DEN[l]), EMT[l]); float ss = 0.f; DBGCHK(dws, 9, acc[0][0] + acc[1][1] + acc[2][2] + acc[3][3]); DBGCHK(dws, 10, DEN[l]); DBGCHK(dws, 11, inv);
#pragma unroll
      for (int j = 0; j < 4; ++j) { acc[j] = acc[j] * inv; ss += (acc[j][0] * acc[j][0] + acc[j][1] * acc[j][1]) + (acc[j][2] * acc[j][2] + acc[j][3] * acc[j][3]); }
      ss += lx_xor(ss, 16, lane); ss += lx_xor(ss, 32, lane);
      if (fq == 0) SSQ[l * 2 + (wave >> 2)] = ss; }
    __syncthreads();
    { const int lt = wave & 3, l = 16 * lt + fr; const float rs = rsqrtf((SSQ[l * 2] + SSQ[l * 2 + 1]) * (1.f / 128.f) + EPS);
#pragma unroll
      for (int j = 0; j < 4; ++j) { const int vt = (wave >> 2) * 4 + j; const size_t off = (r0 + l) * DM + h * 128 + 16 * vt + 4 * fq;
          const v2u mo = *(const v2u*)(MO + off); v2u w;
          DBGCHK(dws, 12, rs); DBGCHK(dws, 13, bflo(mo.x) + bfhi(mo.x) + bflo(mo.y) + bfhi(mo.y));
          w.x = pkbf(acc[j][0] * rs * sigmf(bflo(mo.x)), acc[j][1] * rs * sigmf(bfhi(mo.x))); w.y = pkbf(acc[j][2] * rs * sigmf(bflo(mo.y)), acc[j][3] * rs * sigmf(bfhi(mo.y)));
          *(v2u*)(MV + off) = w; } }
    __syncthreads();
}
__device__ __forceinline__ void ya_norm_row(bf16* YA, size_t row, int lane) {
    v4u* p = (v4u*)(YA + row * DM + 16 * lane); v4u a = p[0], b = p[1]; float f[16];
#pragma unroll
    for (int e = 0; e < 4; ++e) { f[2 * e] = bflo(a[e]); f[2 * e + 1] = bfhi(a[e]); f[8 + 2 * e] = bflo(b[e]); f[8 + 2 * e + 1] = bfhi(b[e]); }
    float ss = 0.f;
#pragma unroll
    for (int e = 0; e < 16; ++e) ss += f[e] * f[e];
    ss += lx_xor(ss, 1, lane); ss += lx_xor(ss, 2, lane); ss += lx_xor(ss, 4, lane);
    const float rs = rsqrtf(ss * (1.f / 128.f) + EPS);
#pragma unroll
    for (int e = 0; e < 4; ++e) { a[e] = pkbf(f[2 * e] * rs, f[2 * e + 1] * rs); b[e] = pkbf(f[8 + 2 * e] * rs, f[8 + 2 * e + 1] * rs); }
    p[0] = a; p[1] = b;
}

#ifndef DBG_SKIP
#define DBG_SKIP 0
#endif
#ifndef MK_ONE_LAUNCH
#define MK_ONE_LAUNCH 1
#endif
constexpr int NPHASE = 1 + 20 * DEPTH;
__global__ void __launch_bounds__(NTHR, 2) mega_fwd(Args args) {
    extern __shared__ __attribute__((aligned(16))) unsigned char lds[];
    cg::grid_group grid = cg::this_grid();
    LAS unsigned char* L = (LAS unsigned char*)lds;
    const int G = gridDim.x, bx = blockIdx.x; const int vcu = (G % 8 == 0) ? (bx % 8) * (G / 8) + bx / 8 : bx;
    const int lo = args.ph_lo, hi = args.ph_hi;
    volatile LAS unsigned* MISC = (volatile LAS unsigned*)(L + RING_BYTES + 512);
    if (threadIdx.x < 64) MISC[threadIdx.x] = 0u;
    __syncthreads();
    XcdBarrier bar = xcd_barrier_post((unsigned*)(args.ws + 4096 * 4), MISC + 8);
    if (hi - lo > 1) grid.sync();
    for (int ph = lo; ph < hi; ++ph) {
            int tid_ = threadIdx.x; asm volatile("" : "+v"(tid_)); const int tid = tid_, lane = tid & 63, wave = __builtin_amdgcn_readfirstlane(tid >> 6), gw = bx * NWAVES + wave, ngw = G * NWAVES;
        int zz = 0; asm volatile("" : "+s"(zz));
            unsigned char* ws = args.ws + zz; float* const outp = args.out + zz;
        bf16* XN = (bf16*)(ws + WS_XN); float* GATES = (float*)(ws + WS_GATES); bf16* CST = (bf16*)(ws + WS_CST); float* NL = (float*)(ws + WS_NL);
        float* BLs = (float*)(ws + WS_BL); float* MLs = (float*)(ws + WS_ML); float* MPs = (float*)(ws + WS_MP);
        bf16* YA = (bf16*)(ws + WS_YA); bf16* ACT = (bf16*)(ws + WS_ACT); bf16* Y = (bf16*)(ws + WS_Y);
        bf16* AQ = (bf16*)(ws + WS_Z); bf16* AK = (bf16*)(ws + WS_Z + ZSTRIDE); bf16* AV = (bf16*)(ws + WS_Z + 2 * ZSTRIDE); bf16* MQK = (bf16*)(ws + WS_Z + 3 * ZSTRIDE);
        bf16* MV = (bf16*)(ws + WS_Z + 4 * ZSTRIDE); bf16* MO = (bf16*)(ws + WS_Z + 5 * ZSTRIDE); bf16* GLA = (bf16*)(ws + WS_Z + 6 * ZSTRIDE); bf16* GLM = (bf16*)(ws + WS_Z + 7 * ZSTRIDE);
        bf16* MERGED = AQ; bf16* YO = AK;
        if (ph == 0) {
            if (!(DBG_SKIP & 8)) { LAS float* scr = (LAS float*)(L + wave * 16384);
            for (int it = gw; it < DEPTH * IT_LAYER; it += ngw) convert_item(args, it, scr, lane);
            for (int i = bx * NTHR + tid; i < DEPTH * 16 * 1024; i += G * NTHR) { const int l = i >> 14, j = (i >> 10) & 15, k = i & 1023;
                ((bf16*)(ws + WS_WG))[i] = (bf16)(pkbf(args.in[(6) + zz][(size_t)l * DM * CIN + (size_t)k * CIN + 6144 + j], 0.f) & 0xffffu); }
            row_phase(args.in[(0) + zz], nullptr, nullptr, 0.f, nullptr, args.in[(1) + zz], XN, 0, M, nullptr, nullptr, nullptr, nullptr, gw, ngw, lane); }
        } else {
            const int l = (ph - 1) / 20, p = (ph - 1) % 20;
            unsigned char* wb = ws + WS_W + (size_t)l * W_LSTRIDE;
            if ((p == 0 || p == 17)) {  if (!(DBG_SKIP & 1)) {
                pg8::Gemm g{XN, (const bf16*)(wb + (p == 0 ? WO_GU1 : WO_GU2)), M, 2 * FF, DM}; pg8::StaticOrder S; S.init(M, 2 * FF, G, bx);
                pg8::EpiSwiglu E{ACT, FF};
                pg8::gemm_phase<pg8::EpiSwiglu, pg8::StaticOrder, PG8_ALIGN, PG8_SP2>(L, g, S, E); }
            } else if (p == 1 || p == 18 || p == 3 || p == 10 || p == 8 || p == 15) {
                if (!(DBG_SKIP & 1)) { pg8::Gemm g; pg8::StaticOrder S; pg8::EpiBf16<0> E;
                if (p == 1 || p == 18) { g = pg8::Gemm{ACT, (const bf16*)(wb + (p == 1 ? WO_DN1 : WO_DN2)), M, DM, FF}; S.init(M, DM, G, bx); E = pg8::EpiBf16<0>{Y, DM, nullptr, 0, 0, 1.f}; }
                else if (p == 3 || p == 10) { const int hb = (p == 10);
                    gates_phase(XN, (const bf16*)(ws + WS_WG) + (size_t)l * 16 * DM, args.in[(14) + zz] + l * 8, args.in[(15) + zz] + l * 8, GATES, hb * MH, MH, gw, ngw, lane);
                    g = pg8::Gemm{XN + (size_t)hb * MH * DM, (const bf16*)(wb + WO_WIN), MH, 8192, DM}; S.init(MH, 8192, G, bx);
                    E = pg8::EpiBf16<0>{AQ, DM, nullptr, DM, ZSTRIDE / 2, attn_body::C2}; }
                else { g = pg8::Gemm{MERGED, (const bf16*)(wb + WO_WO), MH, DM, DM}; S.init(MH, DM, G, bx); E = pg8::EpiBf16<0>{YO, DM, nullptr, 0, 0, 1.f}; }
                pg8::gemm_phase<pg8::EpiBf16<0>, pg8::StaticOrder, PG8_ALIGN, PG8_SP2>(L, g, S, E); }
            } else if (p == 2 || p == 19 || p == 9 || p == 16) {    if (!(DBG_SKIP & 8)) {
                if (p == 2) row_phase(l == 0 ? args.in[(0) + zz] : outp, outp, Y, 0.5f, args.in[(4) + zz] + l * DM, args.in[(5) + zz] + l * DM, XN, 0, M,
                                      nullptr, nullptr, nullptr, nullptr, gw, ngw, lane);
                else if (p == 19) row_phase(outp, outp, Y, 0.5f, args.in[(25) + zz] + l * DM, (l + 1 < DEPTH) ? args.in[(1) + zz] + (l + 1) * DM : nullptr, XN, 0, M, nullptr, nullptr, nullptr, nullptr, gw, ngw, lane);
                else { const int hb = (p == 16); row_phase(outp, outp, YO - (size_t)hb * MH * DM, 1.0f, args.in[(21) + zz] + l * DM, args.in[(22) + zz] + l * DM, XN, hb * MH, MH, nullptr, nullptr, nullptr, nullptr, gw, ngw, lane); } }
            } else {
                const int hb = (p >= 10), q = p - (hb ? 10 : 3);
                const float* GATESh = GATES + (size_t)hb * MH * 16; const float* cw = args.in[(12) + zz] + l * 4 * 1024; const float* cb = args.in[(13) + zz] + l * 1024;
                if (q == 1) {
#ifdef DBG_DUP_M1
                    for (int rep_ = 0; rep_ < DBG_DUP_M1; ++rep_)
#endif
                    if (!(DBG_SKIP & 4)) for (int u = bx; u < 2048; u += G) m1_unit(L, u, MQK, MV, GATESh, cw, cb, CST, NL, BLs, MLs, tid, ws);
                    const float lam_init = 0.8f - 0.6f * expf(-0.3f * (float)l); float d1 = 0.f, d2 = 0.f;
                    for (int i = 0; i < 64; ++i) { d1 += args.in[(7) + zz][l * 64 + i] * args.in[(8) + zz][l * 64 + i]; d2 += args.in[(9) + zz][l * 64 + i] * args.in[(10) + zz][l * 64 + i]; }
                    const float lam = expf(d1) - expf(d2) + lam_init;
                    const int nun = (G == 256) ? 4 : (1024 - bx + G - 1) / G;
#ifdef DBG_DUP_ATT
                    for (int rep_ = 0; rep_ < DBG_DUP_ATT; ++rep_)
#endif
                    if (!(DBG_SKIP & 2))
                    for (int i2 = 0; i2 < 2 * nun; ++i2) { const int i = i2 >> 1, pass = i2 & 1; int combo, qb;
                        if (G == 256) { const int s = vcu & 3; combo = vcu >> 2; qb = (i == 0) ? 15 - s : (i == 1) ? 8 + s : (i == 2) ? 7 - s : s; }
                        else { const int uu = bx + i * G; combo = uu >> 4; qb = uu & 15; }
                        const int vh = combo & 1, h = (combo >> 1) & 7, bl = combo >> 4;
                        attn_body::attn_unit<8>(bl, 2 * h + pass, 2 * h + vh, qb, (const attn_body::bf16*)AQ, (const attn_body::bf16*)AK, (const attn_body::bf16*)AV, (attn_body::bf16*)YA, (char*)lds, pass, lam); }
                } else if (q == 2) {
                    if (!(DBG_SKIP & 4)) for (int it = bx; it < 256; it += G) m2_item(it, (unsigned*)CST, NL, BLs, MLs, MPs, tid, ws);
                } else if (q == 3) {
                    if (!(DBG_SKIP & 4)) for (int u = bx; u < 2048; u += G) m3_unit(L, u, MQK, MV, MO, GATESh, cw, cb, CST, NL, MPs, tid, ws);
                    for (int r = gw; r < MH; r += ngw) ya_norm_row(YA, (size_t)r, lane);
                } else {
                    if (!(DBG_SKIP & 16)) { pg8::StaticOrder S; S.init(MH, DM, G, bx);
                    { pg8::Gemm g{YA, (const bf16*)(wb + WO_WA), MH, DM, DM}; pg8::EpiMerge<0> E{MERGED, GLA, args.in[(19) + zz] + l * 2 * DM};
                      pg8::gemm_phase<pg8::EpiMerge<0>, pg8::StaticOrder, PG8_ALIGN, PG8_SP2>(L, g, S, E); }
                    { pg8::Gemm g{MV, (const bf16*)(wb + WO_WM), MH, DM, DM}; pg8::EpiMerge<1> E{MERGED, GLM, args.in[(19) + zz] + l * 2 * DM + DM};
                      pg8::gemm_phase<pg8::EpiMerge<1>, pg8::StaticOrder, PG8_ALIGN, PG8_SP2>(L, g, S, E); } }
                }
            }
        }
        if (ph + 1 < hi) xcd_barrier(bar);
    }
#ifdef DBG_CODES
    if (blockIdx.x == 0 && threadIdx.x == 0) { asm volatile("s_waitcnt vmcnt(0)" ::: "memory"); const unsigned d = __hip_atomic_load((unsigned*)(args.ws + 40960), __ATOMIC_RELAXED, __HIP_MEMORY_SCOPE_AGENT); if (d) args.out[0] = 1000.f * (float)(100u - d); }
#endif
}

extern "C" void kernel_launch(void* const* d_in, const int* in_sizes, int n_in, void* d_out, int out_size, void* d_ws, size_t ws_size, hipStream_t stream) {
    static int grid = 0;
    if (grid == 0) {
        if (n_in != 26 || in_sizes[0] != M * DM || out_size != M * DM || ws_size < WS_END) { fprintf(stderr, "kernel_launch: unexpected shapes: n_in %d in0 %d out %d ws %zu\n", n_in, n_in > 0 ? in_sizes[0] : -1, out_size, ws_size); grid = -1; return; }
        int dev = 0, cus = 0, per_cu = 0;
        hipGetDevice(&dev); hipDeviceGetAttribute(&cus, hipDeviceAttributeMultiprocessorCount, dev);
        if (hipFuncSetAttribute((const void*)mega_fwd, hipFuncAttributeMaxDynamicSharedMemorySize, LDS_BYTES) != hipSuccess) { fprintf(stderr, "kernel_launch: hipFuncSetAttribute failed\n"); grid = -1; return; }
        if (hipOccupancyMaxActiveBlocksPerMultiprocessor(&per_cu, (const void*)mega_fwd, NTHR, LDS_BYTES) != hipSuccess || per_cu < 1) { fprintf(stderr, "kernel_launch: occupancy query says %d\n", per_cu); per_cu = 1; }
        (void)hipGetLastError();
        grid = cus * per_cu;
    }
    if (grid < 0) return;
    if (hipMemsetAsync(d_ws, 0, 65536, stream) != hipSuccess) { fprintf(stderr, "kernel_launch: memset failed\n"); return; }
    Args a{};
    for (int i = 0; i < 26; ++i) a.in[i] = (const float*)d_in[i];
    a.out = (float*)d_out; a.ws = (unsigned char*)d_ws;
#if MK_ONE_LAUNCH
#ifdef DBG_HI
    a.ph_lo = 0; a.ph_hi = DBG_HI;
#else
    a.ph_lo = 0; a.ph_hi = NPHASE;
#endif
    void* kargs[] = {&a};
    hipError_t e = hipLaunchCooperativeKernel((const void*)mega_fwd, dim3(grid), dim3(NTHR), kargs, LDS_BYTES, stream);
    if (e != hipSuccess) fprintf(stderr, "kernel_launch: cooperative launch failed: %s (grid %d)\n", hipGetErrorString(e), grid);
#else
    for (int ph = 0; ph < NPHASE; ++ph) { a.ph_lo = ph; a.ph_hi = ph + 1; hipLaunchKernelGGL(mega_fwd, dim3(grid), dim3(NTHR), LDS_BYTES, stream, a); }
#endif
}
```
